# Optimizing an MI355X kernel written in HIP

```python
import math
import jax, jax.numpy as jnp
from jax import lax
import numpy as np

D_MODEL = 4096
BATCH = 32
SEQ = 256
DEPTH = 2
DEC_BATCH = 2
DEC_SEQ = 4096
PAST_LEN = 256

GRID_W = 64
BLOCK_Q = 128
ROPE_THETA = 10000.0
LN_EPS = 1e-5
RMS_EPS = 1e-6
NEG_INF = -1e30

W_BRANCH = D_MODEL // 4
D_MIX = 4 * W_BRANCH

A_HEADS = 8
A_DK = W_BRANCH // (2 * A_HEADS)
A_DV = W_BRANCH // A_HEADS

B_HEADS = 8
B_KV = 2
B_DH = W_BRANCH // B_HEADS

D_HEADS = 8
D_KV = 2
D_DH = W_BRANCH // D_HEADS
WINDOW = 128

C_CH = 16
C_GROUPS = W_BRANCH // C_CH
C_STATE = 64

IN_SIZES = (W_BRANCH, W_BRANCH, W_BRANCH, W_BRANCH,
            W_BRANCH, B_KV * B_DH, B_KV * B_DH, W_BRANCH,
            W_BRANCH, W_BRANCH,
            W_BRANCH, D_KV * D_DH, D_KV * D_DH, W_BRANCH)
D_IN = sum(IN_SIZES)
DEEPNORM_ALPHA = (2 * DEPTH) ** 0.25
DEEPNORM_BETA = (8 * DEPTH) ** -0.25

kernel_name = "hybrid_diffusion_parallel_heads_step"


def _layernorm(x):
    xf = x.astype(jnp.float32)
    mu = jnp.mean(xf, -1, keepdims=True)
    var = jnp.mean(jnp.square(xf - mu), -1, keepdims=True)
    return ((xf - mu) * lax.rsqrt(var + LN_EPS)).astype(x.dtype)


def _rmsnorm(x, g):
    xf = x.astype(jnp.float32)
    return (xf * lax.rsqrt(jnp.mean(xf * xf, -1, keepdims=True) + RMS_EPS)).astype(x.dtype) * g


def _rope_tables(rows, cols, d):
    n_freq = d // 4
    inv = ROPE_THETA ** (-jnp.arange(n_freq, dtype=jnp.float32) / n_freq)
    ar = rows[:, None] * inv
    ac = cols[:, None] * inv
    ang = jnp.concatenate([ar, ar, ac, ac], axis=-1)
    return jnp.cos(ang), jnp.sin(ang)


def _apply_rope(x, cos, sin):
    r1, r2, c1, c2 = jnp.split(x, 4, axis=-1)
    rot = jnp.concatenate([-r2, r1, -c2, c1], axis=-1)
    return (x * cos[:, None, :] + rot * sin[:, None, :]).astype(x.dtype)


def _to_blocks(x):
    b, n = x.shape[:2]
    return jnp.moveaxis(x.reshape(b, n // BLOCK_Q, BLOCK_Q, *x.shape[2:]), 1, 0)


def _from_blocks(y):
    nb, b, bq = y.shape[:3]
    return jnp.moveaxis(y, 0, 1).reshape(b, nb * bq, *y.shape[3:])


def _sink_softmax(s, sink):
    sk = sink.astype(jnp.float32)[None, :, :, None, None]
    m = jnp.maximum(jnp.max(s, -1, keepdims=True), sk)
    p = jnp.exp(s - m)
    return p / (jnp.sum(p, -1, keepdims=True) + jnp.exp(sk - m))


def _diff_attention(q, k, v, lam):
    scale = A_DK ** -0.5

    def block(qb):
        s = jnp.einsum('bqhmd,bkhmd->bhmqk', qb, k).astype(jnp.float32) * scale
        a = jax.nn.softmax(s, axis=-1)
        w = a[:, :, 0] - lam * a[:, :, 1]
        return jnp.einsum('bhqk,bkhd->bqhd', w.astype(v.dtype), v)

    return _from_blocks(lax.map(block, _to_blocks(q)))


def _gqa_dense(q, k, v, sink=None):
    scale = q.shape[-1] ** -0.5

    def block(qb):
        s = jnp.einsum('bqhgd,bkhd->bhgqk', qb, k).astype(jnp.float32) * scale
        a = jax.nn.softmax(s, axis=-1) if sink is None else _sink_softmax(s, sink)
        return jnp.einsum('bhgqk,bkhd->bqhgd', a.astype(v.dtype), v)

    return _from_blocks(lax.map(block, _to_blocks(q)))


def _gqa_window(q, k_lat, v_lat, k_ctx, v_ctx, sink):
    n = q.shape[1]
    n_ctx = k_ctx.shape[1]
    span = BLOCK_Q + 2 * WINDOW
    pad = ((0, 0), (WINDOW, WINDOW), (0, 0), (0, 0))
    kp = jnp.pad(k_lat, pad)
    vp = jnp.pad(v_lat, pad)
    scale = q.shape[-1] ** -0.5
    ctx_mask = jnp.ones((BLOCK_Q, n_ctx), dtype=bool)

    def block(args):
        i, qb = args
        start = i * BLOCK_Q
        kb = jnp.concatenate([lax.dynamic_slice_in_dim(kp, start, span, axis=1), k_ctx], axis=1)
        vb = jnp.concatenate([lax.dynamic_slice_in_dim(vp, start, span, axis=1), v_ctx], axis=1)
        q_pos = start + jnp.arange(BLOCK_Q)
        k_pos = start - WINDOW + jnp.arange(span)
        band = (k_pos[None, :] >= 0) & (k_pos[None, :] < n) & (jnp.abs(q_pos[:, None] - k_pos[None, :]) <= WINDOW)
        mask = jnp.concatenate([band, ctx_mask], axis=-1)
        s = jnp.einsum('bqhgd,bkhd->bhgqk', qb, kb).astype(jnp.float32) * scale
        s = jnp.where(mask, s, NEG_INF)
        a = _sink_softmax(s, sink)
        return jnp.einsum('bhgqk,bkhd->bqhgd', a.astype(vb.dtype), vb)

    nb = n // BLOCK_Q
    return _from_blocks(lax.map(block, (jnp.arange(nb), _to_blocks(q))))


def _s5_discretize(lam_re, lam_im, log_dt, b_re, b_im):
    f32 = jnp.float32
    lam_re, lam_im, b_re, b_im = (t.astype(f32) for t in (lam_re, lam_im, b_re, b_im))
    dt = jnp.exp(log_dt.astype(f32))[:, None]
    mag = jnp.exp(lam_re * dt)
    a_re = mag * jnp.cos(lam_im * dt)
    a_im = mag * jnp.sin(lam_im * dt)
    den = lam_re * lam_re + lam_im * lam_im
    nr = a_re - 1.0
    f_re = (nr * lam_re + a_im * lam_im) / den
    f_im = (a_im * lam_re - nr * lam_im) / den
    bb_re = f_re[..., None] * b_re - f_im[..., None] * b_im
    bb_im = f_re[..., None] * b_im + f_im[..., None] * b_re
    return a_re, a_im, bb_re, bb_im


def _complex_combine(e1, e2):
    a1r, a1i, b1r, b1i = e1
    a2r, a2i, b2r, b2i = e2
    return (a2r * a1r - a2i * a1i, a2r * a1i + a2i * a1r,
            a2r * b1r - a2i * b1i + b2r, a2r * b1i + a2i * b1r + b2i)


def _s5_branch(u, gate, lp, h0=None):
    f32 = jnp.float32
    b, n = u.shape[:2]
    uf = u.astype(f32).reshape(b, n, C_GROUPS, C_CH)
    y = uf * lp['c_d'].astype(f32).reshape(C_GROUPS, C_CH)
    fin_re, fin_im = [], []
    for d in range(2):
        a_re, a_im, bb_re, bb_im = _s5_discretize(lp['c_lam_re'][d], lp['c_lam_im'][d], lp['c_log_dt'][d],
                                                  lp['c_b_re'][d], lp['c_b_im'][d])
        ud = uf if d == 0 else jnp.flip(uf, axis=1)
        bu_re = jnp.einsum('gpc,blgc->blgp', bb_re, ud)
        bu_im = jnp.einsum('gpc,blgc->blgp', bb_im, ud)
        if h0 is not None:
            h_re = h0[0][:, d].astype(f32)
            h_im = h0[1][:, d].astype(f32)
            bu_re = bu_re.at[:, 0].add(a_re * h_re - a_im * h_im)
            bu_im = bu_im.at[:, 0].add(a_re * h_im + a_im * h_re)
        elems = (jnp.broadcast_to(a_re, bu_re.shape), jnp.broadcast_to(a_im, bu_im.shape), bu_re, bu_im)
        _, _, hr, hi = lax.associative_scan(_complex_combine, elems, axis=1)
        if h0 is None:
            fin_re.append(hr[:, -1])
            fin_im.append(hi[:, -1])
        if d == 1:
            hr = jnp.flip(hr, axis=1)
            hi = jnp.flip(hi, axis=1)
        c_re = lp['c_c_re'][d].astype(f32)
        c_im = lp['c_c_im'][d].astype(f32)
        y = y + jnp.einsum('gcp,blgp->blgc', c_re, hr) - jnp.einsum('gcp,blgp->blgc', c_im, hi)
    y = jax.nn.gelu(y.reshape(b, n, W_BRANCH))
    y = y * jax.nn.sigmoid(y @ lp['c_glu_w'].astype(f32) + lp['c_glu_b'].astype(f32))
    out = y.astype(u.dtype) * jax.nn.silu(gate)
    finals = (jnp.stack(fin_re, axis=1), jnp.stack(fin_im, axis=1)) if h0 is None else None
    return out, finals


def _mixer_inputs(x, cond, lp):
    ada = jax.nn.silu(cond) @ lp['w_ada'] + lp['b_ada']
    shift, scale, gate = jnp.split(ada[:, None, :], 3, axis=-1)
    h = _layernorm(x) * (1.0 + scale) + shift
    idx = np.cumsum(IN_SIZES)[:-1].tolist()
    return jnp.split(h @ lp['w_in'], idx, axis=-1), gate


def _residual(x, outs, gate, lp):
    y = jnp.concatenate(outs, axis=-1) @ lp['w_out']
    return _layernorm(DEEPNORM_ALPHA * x + gate * y) * lp['ln_g'] + lp['ln_b']


def _diff_lambda(lp, lam_init):
    f = lambda t: t.astype(jnp.float32)
    return (jnp.exp(jnp.sum(f(lp['a_lam_q1']) * f(lp['a_lam_k1'])))
            - jnp.exp(jnp.sum(f(lp['a_lam_q2']) * f(lp['a_lam_k2']))) + lam_init)


def _diff_output(o, lp, lam_init, gate):
    b, n = o.shape[:2]
    return (_rmsnorm(o, lp['a_subln_g']) * (1.0 - lam_init)).reshape(b, n, W_BRANCH) * jax.nn.silu(gate)


def _context_layer(x, c_ctx, lp, lam_init):
    b, n = x.shape[:2]
    parts, gate = _mixer_inputs(x, c_ctx[None], lp)
    a_q, a_k, a_v, a_g, b_q, b_k, b_v, b_g, c_u, c_g, d_q, d_k, d_v, d_g = parts
    ak = a_k.reshape(b, n, A_HEADS, 2, A_DK)
    av = a_v.reshape(b, n, A_HEADS, A_DV)
    lam = _diff_lambda(lp, lam_init)
    out_a = _diff_output(_diff_attention(a_q.reshape(b, n, A_HEADS, 2, A_DK), ak, av, lam), lp, lam_init, a_g)
    bq = _rmsnorm(b_q.reshape(b, n, B_HEADS, B_DH), lp['b_qnorm_g']).reshape(b, n, B_KV, B_HEADS // B_KV, B_DH)
    bk = _rmsnorm(b_k.reshape(b, n, B_KV, B_DH), lp['b_knorm_g'])
    bv = b_v.reshape(b, n, B_KV, B_DH)
    out_b = _gqa_dense(bq, bk, bv).reshape(b, n, W_BRANCH) * jax.nn.silu(b_g)
    out_c, (s_re, s_im) = _s5_branch(c_u, c_g, lp)
    dq = d_q.reshape(b, n, D_KV, D_HEADS // D_KV, D_DH)
    dk = d_k.reshape(b, n, D_KV, D_DH)
    dv = d_v.reshape(b, n, D_KV, D_DH)
    out_d = _gqa_dense(dq, dk, dv, sink=lp['d_sink'].reshape(D_KV, D_HEADS // D_KV)).reshape(b, n, W_BRANCH) * jax.nn.silu(d_g)
    y = _residual(x, (out_a, out_b, out_c, out_d), gate, lp)
    return y, (ak.reshape(b, n, A_HEADS, 2 * A_DK), av, bk, bv, dk, dv, s_re, s_im)


def _latent_layer(x, c, ctx, lp, lam_init, rope_a, rope_h):
    b, n = x.shape[:2]
    ak_c, av_c, bk_c, bv_c, dk_c, dv_c, s_re_c, s_im_c = ctx
    m = ak_c.shape[1]
    parts, gate = _mixer_inputs(x, c, lp)
    a_q, a_k, a_v, a_g, b_q, b_k, b_v, b_g, c_u, c_g, d_q, d_k, d_v, d_g = parts
    aq = _apply_rope(a_q.reshape(b, n, 2 * A_HEADS, A_DK), *rope_a).reshape(b, n, A_HEADS, 2, A_DK)
    ak = _apply_rope(a_k.reshape(b, n, 2 * A_HEADS, A_DK), *rope_a).reshape(b, n, A_HEADS, 2, A_DK)
    ak_all = jnp.concatenate([ak, ak_c.reshape(b, m, A_HEADS, 2, A_DK)], axis=1)
    av_all = jnp.concatenate([a_v.reshape(b, n, A_HEADS, A_DV), av_c], axis=1)
    lam = _diff_lambda(lp, lam_init)
    out_a = _diff_output(_diff_attention(aq, ak_all, av_all, lam), lp, lam_init, a_g)
    bq = _apply_rope(_rmsnorm(b_q.reshape(b, n, B_HEADS, B_DH), lp['b_qnorm_g']), *rope_h)
    bq = bq.reshape(b, n, B_KV, B_HEADS // B_KV, B_DH)
    bk = _apply_rope(_rmsnorm(b_k.reshape(b, n, B_KV, B_DH), lp['b_knorm_g']), *rope_h)
    bk_all = jnp.concatenate([bk, bk_c], axis=1)
    bv_all = jnp.concatenate([b_v.reshape(b, n, B_KV, B_DH), bv_c], axis=1)
    out_b = _gqa_dense(bq, bk_all, bv_all).reshape(b, n, W_BRANCH) * jax.nn.silu(b_g)
    out_c, _ = _s5_branch(c_u, c_g, lp, h0=(s_re_c, s_im_c))
    dq = _apply_rope(d_q.reshape(b, n, D_HEADS, D_DH), *rope_h).reshape(b, n, D_KV, D_HEADS // D_KV, D_DH)
    dk = _apply_rope(d_k.reshape(b, n, D_KV, D_DH), *rope_h)
    dv = d_v.reshape(b, n, D_KV, D_DH)
    out_d = _gqa_window(dq, dk, dv, dk_c, dv_c, lp['d_sink'].reshape(D_KV, D_HEADS // D_KV))
    out_d = out_d.reshape(b, n, W_BRANCH) * jax.nn.silu(d_g)
    return _residual(x, (out_a, out_b, out_c, out_d), gate, lp)


def setup_inputs(seed: int = 0) -> dict:
    key = jax.random.key(seed)
    ks = iter(jax.random.split(key, 48))
    f32 = jnp.float32

    def nrm(shape, s=1.0):
        return s * jax.random.normal(next(ks), shape, f32)

    inp = {}
    inp['x_prompt'] = nrm((BATCH, SEQ, D_MODEL))
    inp['x_sample'] = nrm((DEC_BATCH, DEC_SEQ, D_MODEL))
    inp['c'] = nrm((DEC_BATCH, D_MODEL))
    inp['cache_a_k'] = nrm((DEC_BATCH, DEPTH, PAST_LEN, A_HEADS, 2 * A_DK))
    inp['cache_a_v'] = nrm((DEC_BATCH, DEPTH, PAST_LEN, A_HEADS, A_DV))
    inp['cache_b_k'] = nrm((DEC_BATCH, DEPTH, PAST_LEN, B_KV, B_DH))
    inp['cache_b_v'] = nrm((DEC_BATCH, DEPTH, PAST_LEN, B_KV, B_DH))
    inp['cache_d_k'] = nrm((DEC_BATCH, DEPTH, PAST_LEN, D_KV, D_DH))
    inp['cache_d_v'] = nrm((DEC_BATCH, DEPTH, PAST_LEN, D_KV, D_DH))
    inp['state_c_re'] = nrm((DEC_BATCH, DEPTH, 2, C_GROUPS, C_STATE), 0.1)
    inp['state_c_im'] = nrm((DEC_BATCH, DEPTH, 2, C_GROUPS, C_STATE), 0.1)
    inp['c_ctx'] = nrm((D_MODEL,))
    inp['w_ada'] = nrm((DEPTH, D_MODEL, 3 * D_MODEL), 0.5 * D_MODEL ** -0.5)
    inp['b_ada'] = nrm((DEPTH, 3 * D_MODEL), 0.01)
    inp['w_in'] = nrm((DEPTH, D_MODEL, D_IN), D_MODEL ** -0.5)
    inp['w_out'] = nrm((DEPTH, D_MIX, D_MODEL), DEEPNORM_BETA * D_MIX ** -0.5)
    inp['ln_g'] = 1.0 + nrm((DEPTH, D_MODEL), 0.01)
    inp['ln_b'] = nrm((DEPTH, D_MODEL), 0.01)
    inp['a_lam_q1'] = nrm((DEPTH, A_DK), 0.1)
    inp['a_lam_k1'] = nrm((DEPTH, A_DK), 0.1)
    inp['a_lam_q2'] = nrm((DEPTH, A_DK), 0.1)
    inp['a_lam_k2'] = nrm((DEPTH, A_DK), 0.1)
    inp['a_subln_g'] = 1.0 + nrm((DEPTH, A_DV), 0.01)
    inp['b_qnorm_g'] = 1.0 + nrm((DEPTH, B_DH), 0.01)
    inp['b_knorm_g'] = 1.0 + nrm((DEPTH, B_DH), 0.01)
    inp['d_sink'] = nrm((DEPTH, D_HEADS), 0.5)
    inp['c_lam_re'] = -0.5 + nrm((DEPTH, 2, C_GROUPS, C_STATE), 0.01)
    inp['c_lam_im'] = jnp.pi * jnp.arange(C_STATE, dtype=f32) + nrm((DEPTH, 2, C_GROUPS, C_STATE), 0.01)
    inp['c_log_dt'] = jax.random.uniform(next(ks), (DEPTH, 2, C_GROUPS), f32,
                                         minval=math.log(1e-3), maxval=math.log(1e-1))
    inp['c_b_re'] = nrm((DEPTH, 2, C_GROUPS, C_STATE, C_CH), (2 * C_CH) ** -0.5)
    inp['c_b_im'] = nrm((DEPTH, 2, C_GROUPS, C_STATE, C_CH), (2 * C_CH) ** -0.5)
    inp['c_c_re'] = nrm((DEPTH, 2, C_GROUPS, C_CH, C_STATE), (2 * C_STATE) ** -0.5)
    inp['c_c_im'] = nrm((DEPTH, 2, C_GROUPS, C_CH, C_STATE), (2 * C_STATE) ** -0.5)
    inp['c_d'] = nrm((DEPTH, W_BRANCH))
    inp['c_glu_w'] = nrm((DEPTH, W_BRANCH, W_BRANCH), W_BRANCH ** -0.5)
    inp['c_glu_b'] = nrm((DEPTH, W_BRANCH), 0.01)
    return inp


def reference(x_prompt, x_sample, c, cache_a_k, cache_a_v, cache_b_k, cache_b_v, cache_d_k, cache_d_v,
              state_c_re, state_c_im, c_ctx, w_ada, b_ada, w_in, w_out, ln_g, ln_b,
              a_lam_q1, a_lam_k1, a_lam_q2, a_lam_k2, a_subln_g, b_qnorm_g, b_knorm_g, d_sink,
              c_lam_re, c_lam_im, c_log_dt, c_b_re, c_b_im, c_c_re, c_c_im, c_d, c_glu_w, c_glu_b):
    layers = []
    for l in range(DEPTH):
        layers.append(dict(w_ada=w_ada[l], b_ada=b_ada[l], w_in=w_in[l], w_out=w_out[l], ln_g=ln_g[l], ln_b=ln_b[l],
                           a_lam_q1=a_lam_q1[l], a_lam_k1=a_lam_k1[l], a_lam_q2=a_lam_q2[l], a_lam_k2=a_lam_k2[l],
                           a_subln_g=a_subln_g[l], b_qnorm_g=b_qnorm_g[l], b_knorm_g=b_knorm_g[l], d_sink=d_sink[l],
                           c_lam_re=c_lam_re[l], c_lam_im=c_lam_im[l], c_log_dt=c_log_dt[l],
                           c_b_re=c_b_re[l], c_b_im=c_b_im[l], c_c_re=c_c_re[l], c_c_im=c_c_im[l],
                           c_d=c_d[l], c_glu_w=c_glu_w[l], c_glu_b=c_glu_b[l]))
    lam_inits = [0.8 - 0.6 * math.exp(-0.3 * l) for l in range(DEPTH)]

    y_prompt = x_prompt
    ctx_list = []
    for l in range(DEPTH):
        y_prompt, ctx_t = _context_layer(y_prompt, c_ctx, layers[l], lam_inits[l])
        ctx_list.append(ctx_t)
    ns = [jnp.stack(z, axis=1) for z in zip(*ctx_list)]

    n_lat = x_sample.shape[1]
    n_rows = n_lat // GRID_W
    rows = jnp.repeat(jnp.arange(n_rows, dtype=jnp.float32), GRID_W)
    cols = jnp.tile(jnp.arange(GRID_W, dtype=jnp.float32), n_rows)
    rope_a = _rope_tables(rows, cols, A_DK)
    rope_h = _rope_tables(rows, cols, B_DH)
    y_sample = x_sample
    for l in range(DEPTH):
        ctx_l = (cache_a_k[:, l], cache_a_v[:, l], cache_b_k[:, l], cache_b_v[:, l],
                 cache_d_k[:, l], cache_d_v[:, l], state_c_re[:, l], state_c_im[:, l])
        y_sample = _latent_layer(y_sample, c, ctx_l, layers[l], lam_inits[l], rope_a, rope_h)

    return (y_prompt, y_sample, ns[0], ns[1], ns[2], ns[3], ns[4], ns[5], ns[6], ns[7])
```

```cpp
#include <hip/hip_runtime.h>
#include <cstdio>
#include <cstdint>
__device__ __forceinline__ int lane_id() { int l; asm volatile("v_mbcnt_lo_u32_b32 %0, -1, 0\n\tv_mbcnt_hi_u32_b32 %0, -1, %0" : "=v"(l)); return l; }
__device__ __forceinline__ int tid_of(int wv) { return (wv << 6) | lane_id(); }
namespace pg8 {
#define PG8_LAS __attribute__((address_space(3)))
typedef unsigned short bf16_t;
typedef short bf16x8 __attribute__((ext_vector_type(8)));
typedef float f32x4 __attribute__((ext_vector_type(4)));
typedef unsigned u32x4 __attribute__((ext_vector_type(4)));
constexpr int BM = 256, BK = 64, HALF = 128, HTB = HALF * BK * 2  , STAGE_BYTES = 8 * HTB, NXCD = 8, WGM = 8;

__host__ __device__ __forceinline__ int lds_byte(int r, int c) { const int st = (r >> 4) * 2 + (c >> 5), rr = r & 15, cc = c & 31, ob = rr * 64 + cc * 2; return st * 1024 + (ob ^ (((ob >> 9) & 1) << 5)); }
__host__ __device__ __forceinline__ void stage_rc(int b, int& R, int& C) { const int st = b / 1024, sb = b % 1024, swz = sb ^ (((sb >> 9) & 1) << 5); R = (st >> 1) * 16 + swz / 64; C = (st & 1) * 32 + (swz % 64) / 2; }
__host__ __device__ __forceinline__ int perm32(int rho) { const int n = rho >> 4, i = rho & 15; return 8 * (i >> 2) + 4 * n + (i & 3); }

struct Unit { int pm, pn; };
struct Gemm { const bf16_t* A; const bf16_t* Bt; int M, N, K; };

struct StaticOrder {
    int nM, nN, nwg, G, c;
    __host__ __device__ void init(int M, int N, int G_, int c_) { nM = M / BM; nN = N / BM; nwg = nM * nN; G = G_; c = c_; }
    __host__ __device__ bool next(int i, Unit& u) const {
        const long L = (long)i * G + c; if (L >= nwg) return false;
        int wgid = (int)L; { const int q = nwg / NXCD, r = nwg % NXCD, xcd = wgid % NXCD, off = wgid / NXCD; wgid = (xcd < r ? xcd * (q + 1) : r * (q + 1) + (xcd - r) * q) + off; }
        const int nig = WGM * nN, gid = wgid / nig, fm = gid * WGM, gsz = (nM - fm) < WGM ? (nM - fm) : WGM;
        u.pm = fm + ((wgid % nig) % gsz); u.pn = (wgid % nig) / gsz; return true;
    }
    __device__ __forceinline__ void a_ready(const Unit&) const {}
    __device__ __forceinline__ void done(const Unit&) const {}
};

__device__ __forceinline__ unsigned cvt_pk_bf16(float lo, float hi) { unsigned r; asm volatile("v_cvt_pk_bf16_f32 %0, %1, %2" : "=v"(r) : "v"(lo), "v"(hi)); return r; }
typedef float f32x2 __attribute__((ext_vector_type(2)));
__device__ __forceinline__ f32x2 gelu_pk(f32x2 v) {
    const f32x2 av = __builtin_elementwise_abs(v), d = av * 0.2316418882f + 1.0f;
    f32x2 t; t.x = __builtin_amdgcn_rcpf(d.x); t.y = __builtin_amdgcn_rcpf(d.y);
    f32x2 q = t * 0.5307027145f + (-0.7265760135f); q = q * t + 0.7107068705f; q = q * t + (-0.142248368f); q = q * t + 0.127414796f; q = q * t;
    const f32x2 s = (v * v) * (-0.72134752044f);
    f32x2 e; e.x = __builtin_amdgcn_exp2f(s.x); e.y = __builtin_amdgcn_exp2f(s.y);
    const f32x2 m = v * (q * e), r = v - m;
    f32x2 o; o.x = v.x < 0.f ? m.x : r.x; o.y = v.y < 0.f ? m.y : r.y; return o;
}

template <int ACT  > struct EpiBf16 {
    static constexpr bool PERM = true, AFTER_DRAIN = false; static_assert(ACT == 0 || ACT == 1, "EpiBf16: ACT is 0 (none) or 1 (gelu_pk)");
    bf16_t* O; int ldc; const float* bias; int split_cols; size_t split_stride; float scale0;
    __device__ __forceinline__ void operator()(const f32x4 (&acc)[2][2][4][2], const Unit& u, int wr, int wc, int fr, int fq) const {
        const int row0 = u.pm * BM + wr * 64 + fr; int colt = u.pn * BM; bf16_t* base = O;
        float sc = 1.f; if (split_cols) { const int t = colt / split_cols; base += (size_t)t * split_stride; colt -= t * split_cols; if (t == 0) sc = scale0; }
        const int col0 = colt + wc * 32 + 8 * fq, bcol0 = u.pn * BM + wc * 32 + 8 * fq;
        f32x4 bv[2][2];
#pragma unroll
        for (int bj = 0; bj < 2; ++bj)
#pragma unroll
            for (int n = 0; n < 2; ++n) bv[bj][n] = bias ? *(const f32x4*)(bias + bcol0 + bj * HALF + 4 * n) : (f32x4){0.f, 0.f, 0.f, 0.f};
#pragma unroll
        for (int ai = 0; ai < 2; ++ai)
#pragma unroll
            for (int m = 0; m < 4; ++m) { bf16_t* rowp = base + (size_t)(row0 + ai * HALF + m * 16) * ldc + col0;
#pragma unroll
                for (int bj = 0; bj < 2; ++bj) { f32x4 v0 = acc[ai][bj][m][0] + bv[bj][0], v1 = acc[ai][bj][m][1] + bv[bj][1];
                    if (ACT == 1) { f32x2 a = gelu_pk((f32x2){v0[0], v0[1]}), b = gelu_pk((f32x2){v0[2], v0[3]}), c = gelu_pk((f32x2){v1[0], v1[1]}), d = gelu_pk((f32x2){v1[2], v1[3]});
                        v0 = (f32x4){a.x, a.y, b.x, b.y}; v1 = (f32x4){c.x, c.y, d.x, d.y}; }
                    v0 = v0 * sc; v1 = v1 * sc; u32x4 w; w.x = cvt_pk_bf16(v0[0], v0[1]); w.y = cvt_pk_bf16(v0[2], v0[3]); w.z = cvt_pk_bf16(v1[0], v1[1]); w.w = cvt_pk_bf16(v1[2], v1[3]);
                    __builtin_nontemporal_store(w, (u32x4*)(rowp + bj * HALF)); } }
    }
};

__device__ __forceinline__ float bf_lo(unsigned w) { return __uint_as_float(w << 16); }
__device__ __forceinline__ float bf_hi(unsigned w) { return __uint_as_float(w & 0xffff0000u); }
__device__ __forceinline__ float sigmoid_f(float x) { return __builtin_amdgcn_rcpf(1.f + __expf(-x)); }
__device__ __forceinline__ float silu_f(float x) { return x * __builtin_amdgcn_rcpf(1.f + __expf(-x)); }
struct EpiGlu {
    static constexpr bool PERM = true, AFTER_DRAIN = false;
    bf16_t* MIX; const bf16_t* Y; const bf16_t* PROJ; const float* bias; int ld_mix, ld_y, ld_proj, mix_col0, gate_col0;
    __device__ __forceinline__ void operator()(const f32x4 (&acc)[2][2][4][2], const Unit& u, int wr, int wc, int fr, int fq) const {
        const int row0 = u.pm * BM + wr * 64 + fr, col0 = u.pn * BM + wc * 32 + 8 * fq;
#pragma unroll
        for (int ai = 0; ai < 2; ++ai)
#pragma unroll
            for (int m = 0; m < 4; ++m) { const size_t row = (size_t)(row0 + ai * HALF + m * 16);
#pragma unroll
                for (int bj = 0; bj < 2; ++bj) { const int c = col0 + bj * HALF;
                    const f32x4 b0 = *(const f32x4*)(bias + c), b1 = *(const f32x4*)(bias + c + 4);
                    const u32x4 yv = *(const u32x4*)(Y + row * ld_y + c), gv = *(const u32x4*)(PROJ + row * ld_proj + gate_col0 + c);
                    const f32x4 v0 = acc[ai][bj][m][0] + b0, v1 = acc[ai][bj][m][1] + b1;
                    float o[8]; const float z[8] = {v0[0], v0[1], v0[2], v0[3], v1[0], v1[1], v1[2], v1[3]};
                    const unsigned yw[4] = {yv.x, yv.y, yv.z, yv.w}, gw[4] = {gv.x, gv.y, gv.z, gv.w};
#pragma unroll
                    for (int j = 0; j < 4; ++j) { o[2 * j] = bf_lo(yw[j]) * sigmoid_f(z[2 * j]) * silu_f(bf_lo(gw[j])); o[2 * j + 1] = bf_hi(yw[j]) * sigmoid_f(z[2 * j + 1]) * silu_f(bf_hi(gw[j])); }
                    u32x4 w; w.x = cvt_pk_bf16(o[0], o[1]); w.y = cvt_pk_bf16(o[2], o[3]); w.z = cvt_pk_bf16(o[4], o[5]); w.w = cvt_pk_bf16(o[6], o[7]);
                    *(u32x4*)(MIX + row * ld_mix + mix_col0 + c) = w; } }
    }
};
struct EpiOut {
    static constexpr bool PERM = true, AFTER_DRAIN = false;
    bf16_t* XR; const float* xc; const float* xl; const bf16_t* x16; const float* gate; float alpha;
    __device__ __forceinline__ void operator()(const f32x4 (&acc)[2][2][4][2], const Unit& u, int wr, int wc, int fr, int fq) const {
        const int row0 = u.pm * BM + wr * 64 + fr, col0 = u.pn * BM + wc * 32 + 8 * fq;
        const int v = u.pm < 32 ? 0 : 1 + ((u.pm - 32) >> 4);
        const float* xb = u.pm < 32 ? xc : xl; const int rsub = u.pm < 32 ? 0 : 8192;
#pragma unroll
        for (int bj = 0; bj < 2; ++bj) {
            const f32x4 g0 = *(const f32x4*)(gate + (size_t)v * 12288 + col0 + bj * HALF), g1 = *(const f32x4*)(gate + (size_t)v * 12288 + col0 + bj * HALF + 4);
#pragma unroll
            for (int ai = 0; ai < 2; ++ai)
#pragma unroll
                for (int m = 0; m < 4; ++m) { const size_t off = (size_t)(row0 + ai * HALF + m * 16) * 4096 + col0 + bj * HALF; f32x4 x0, x1;
                    if (x16) { const u32x4 w = *(const u32x4*)(x16 + off); x0 = (f32x4){bf_lo(w.x), bf_hi(w.x), bf_lo(w.y), bf_hi(w.y)}; x1 = (f32x4){bf_lo(w.z), bf_hi(w.z), bf_lo(w.w), bf_hi(w.w)}; }
                    else { const float* xp = xb + (off - (size_t)rsub * 4096); x0 = *(const f32x4*)xp; x1 = *(const f32x4*)(xp + 4); }
                    const f32x4 o0 = x0 * alpha + g0 * acc[ai][bj][m][0], o1 = x1 * alpha + g1 * acc[ai][bj][m][1];
                    u32x4 w; w.x = cvt_pk_bf16(o0[0], o0[1]); w.y = cvt_pk_bf16(o0[2], o0[3]); w.z = cvt_pk_bf16(o1[0], o1[1]); w.w = cvt_pk_bf16(o1[2], o1[3]);
                    *(u32x4*)(XR + off) = w;
                    if (m & 1) asm volatile("" ::: "memory"); }
        }
    }
};
template <class Epi, class Sched, bool ALIGN_EPI = false, bool SP2 = false>
__device__ __forceinline__ void gemm_phase(PG8_LAS unsigned char* lds, const Gemm g, const Sched& S, const Epi& E, int wv) {
    int tid = tid_of(wv); asm volatile("" : "+v"(tid));
    const int wid = __builtin_amdgcn_readfirstlane(tid >> 6), lane = tid & 63, wr = wid >> 2, wc = wid & 3, fr = lane & 15, fq = lane >> 4;
    const int K = g.K, nt = K / BK;
    unsigned voffA[2], voffB[2];
#pragma unroll
    for (int i = 0; i < 2; ++i) { int R, C; stage_rc(tid * 16 + i * 8192, R, C); const int Rb = Epi::PERM ? ((R & ~31) + perm32(R & 31)) : R;
        voffA[i] = (unsigned)(R * K + C) * 2u; voffB[i] = (unsigned)(Rb * K + C) * 2u; }
    const long kstep = (long)(BK * 2);
    long kc = kstep;
    const size_t hstep = (size_t)HALF * K * 2;
    const size_t tstep = 2 * hstep;
    const unsigned ldsw = (unsigned)wid * 1024u;
    const int aoff = lds_byte(wr * 64 + fr, fq * 8), boff = lds_byte(wc * 32 + fr, fq * 8);
#define PG8_SA(b, h) (((b) * 2 + (h)) * HTB)
#define PG8_SB(b, h) ((4 + (b) * 2 + (h)) * HTB)
#define PG8_STAGE(bufoff, gbase, voff) do { _Pragma("unroll") for (int _i = 0; _i < 2; ++_i) \
        __builtin_amdgcn_global_load_lds((const unsigned*)((const char*)(gbase) + (voff)[_i]), (PG8_LAS unsigned*)(lds + (bufoff) + ldsw + _i * 8192), 16, 0, 0); } while (0)
#define PG8_LDA(dst, b, h) do { _Pragma("unroll") for (int m = 0; m < 4; ++m) _Pragma("unroll") for (int k = 0; k < 2; ++k) dst[m][k] = *(const PG8_LAS bf16x8*)(lds + PG8_SA(b, h) + aoff + m * 2048 + k * 1024); } while (0)
#define PG8_LDB(dst, b, h) do { _Pragma("unroll") for (int n = 0; n < 2; ++n) _Pragma("unroll") for (int k = 0; k < 2; ++k) dst[n][k] = *(const PG8_LAS bf16x8*)(lds + PG8_SB(b, h) + boff + n * 2048 + k * 1024); } while (0)
#define PG8_MMA(ai, bj, At, Bt) do { __builtin_amdgcn_s_setprio(1); _Pragma("unroll") for (int m = 0; m < 4; ++m) _Pragma("unroll") for (int n = 0; n < 2; ++n) _Pragma("unroll") for (int k = 0; k < 2; ++k) \
        acc[ai][bj][m][n] = __builtin_amdgcn_mfma_f32_16x16x32_bf16(Bt[n][k], At[m][k], acc[ai][bj][m][n], 0, 0, 0); __builtin_amdgcn_s_setprio(0); } while (0)
#define PG8_WAIT_V(n) asm volatile("s_waitcnt vmcnt(" #n ")" ::: "memory")
#define PG8_WAIT_L(n) asm volatile("s_waitcnt lgkmcnt(" #n ")" ::: "memory")
#define PG8_BAR __builtin_amdgcn_s_barrier()
#define PG8_SCHED __builtin_amdgcn_sched_barrier(0)
    Unit cur, nxt; int ui = 0;
    if (!S.next(0, cur)) return;
    f32x4 acc[2][2][4][2];
#pragma unroll
    for (int a = 0; a < 2; ++a)
#pragma unroll
        for (int b = 0; b < 2; ++b)
#pragma unroll
            for (int m = 0; m < 4; ++m)
#pragma unroll
                for (int n = 0; n < 2; ++n) acc[a][b][m][n] = (f32x4){0.f, 0.f, 0.f, 0.f};
    bf16x8 At[4][2], B0[2][2], B1[2][2];
    const char* cA = (const char*)g.A + (size_t)cur.pm * tstep; const char* cB = (const char*)g.Bt + (size_t)cur.pn * tstep;
    S.a_ready(cur);
    if constexpr (SP2) {
        PG8_STAGE(PG8_SB(0, 0), cB, voffB); PG8_STAGE(PG8_SB(0, 1), cB + hstep, voffB); PG8_STAGE(PG8_SA(0, 0), cA, voffA); PG8_STAGE(PG8_SA(0, 1), cA + hstep, voffA);
        if (wr == 1) PG8_BAR;
        PG8_WAIT_V(2); PG8_BAR;
        PG8_STAGE(PG8_SB(1, 0), cB + kstep, voffB); PG8_STAGE(PG8_SA(1, 0), cA + kstep, voffA); PG8_STAGE(PG8_SB(1, 1), cB + hstep + kstep, voffB);
        PG8_WAIT_V(6); PG8_BAR;
    } else {
        PG8_STAGE(PG8_SB(0, 0), cB, voffB); PG8_STAGE(PG8_SA(0, 0), cA, voffA); PG8_STAGE(PG8_SB(0, 1), cB + hstep, voffB); PG8_STAGE(PG8_SA(0, 1), cA + hstep, voffA);
        if (wr == 1) PG8_BAR;
        PG8_WAIT_V(4); PG8_BAR;
        PG8_STAGE(PG8_SB(1, 0), cB + kstep, voffB); PG8_STAGE(PG8_SA(1, 0), cA + kstep, voffA); PG8_STAGE(PG8_SB(1, 1), cB + hstep + kstep, voffB);
        PG8_WAIT_V(6); PG8_BAR;
    }
    for (;;) {
        const bool has_next = S.next(ui + 1, nxt);
        const bool nrev = has_next && (((ui + 1) & 1) != 0); const long kn = has_next ? (nrev ? -kstep : kstep) : kc; const long noff = nrev ? (long)(nt - 1) * kstep : 0;
        const char* nA = has_next ? (const char*)g.A + (size_t)nxt.pm * tstep + noff : cA; const char* nB = has_next ? (const char*)g.Bt + (size_t)nxt.pn * tstep + noff : cB;
        for (int t = 0; t < nt; t += 2) {
            const bool last = (t == nt - 2);
            const char* a1 = cA + (long)(t + 1) * kc;
            const char* a2 = last ? nA : cA + (long)(t + 2) * kc; const char* b2 = last ? nB : cB + (long)(t + 2) * kc;
            const long k3 = last ? kn : kc; const char* a3 = a2 + k3; const char* b3 = b2 + k3;
            if (last && has_next) S.a_ready(nxt);
            if constexpr (SP2) {
            PG8_LDB(B0, 0, 0); PG8_LDB(B1, 0, 1); PG8_SCHED; PG8_LDA(At, 0, 0); PG8_STAGE(PG8_SA(1, 1), a1 + hstep, voffA);
            PG8_WAIT_V(8); PG8_WAIT_L(0); PG8_BAR; PG8_MMA(0, 0, At, B0); PG8_MMA(0, 1, At, B1); PG8_BAR; PG8_SCHED;
            PG8_LDA(At, 0, 1); PG8_STAGE(PG8_SB(0, 0), b2, voffB); PG8_STAGE(PG8_SB(0, 1), b2 + hstep, voffB); PG8_STAGE(PG8_SA(0, 0), a2, voffA);
            PG8_WAIT_V(8); PG8_WAIT_L(0); PG8_BAR; PG8_MMA(1, 0, At, B0); PG8_MMA(1, 1, At, B1); PG8_BAR; PG8_SCHED;
            PG8_LDB(B0, 1, 0); PG8_LDB(B1, 1, 1); PG8_SCHED; PG8_LDA(At, 1, 0); PG8_STAGE(PG8_SA(0, 1), a2 + hstep, voffA);
            PG8_WAIT_V(8); PG8_WAIT_L(0); PG8_BAR; PG8_MMA(0, 0, At, B0); PG8_MMA(0, 1, At, B1); PG8_BAR; PG8_SCHED;
            PG8_LDA(At, 1, 1); PG8_STAGE(PG8_SB(1, 0), b3, voffB); PG8_STAGE(PG8_SB(1, 1), b3 + hstep, voffB); PG8_STAGE(PG8_SA(1, 0), a3, voffA);
            PG8_WAIT_V(8); PG8_WAIT_L(0); PG8_BAR; PG8_MMA(1, 0, At, B0); PG8_MMA(1, 1, At, B1); PG8_BAR; PG8_SCHED;
            } else {
            PG8_LDB(B0, 0, 0); PG8_SCHED; PG8_LDA(At, 0, 0); PG8_STAGE(PG8_SA(1, 1), a1 + hstep, voffA);
            PG8_WAIT_L(8); PG8_BAR; PG8_WAIT_L(0); PG8_MMA(0, 0, At, B0); PG8_BAR; PG8_SCHED;
            PG8_LDB(B1, 0, 1); PG8_STAGE(PG8_SB(0, 0), b2, voffB);
            PG8_BAR; PG8_WAIT_L(0); PG8_MMA(0, 1, At, B1); PG8_BAR;
            PG8_LDA(At, 0, 1); PG8_STAGE(PG8_SA(0, 0), a2, voffA);
            PG8_BAR; PG8_WAIT_L(0); PG8_MMA(1, 0, At, B0); PG8_BAR; PG8_SCHED;
            PG8_STAGE(PG8_SB(0, 1), b2 + hstep, voffB);
            PG8_WAIT_V(6); PG8_BAR; PG8_MMA(1, 1, At, B1); PG8_BAR;
            PG8_LDB(B0, 1, 0); PG8_SCHED; PG8_LDA(At, 1, 0); PG8_STAGE(PG8_SA(0, 1), a2 + hstep, voffA);
            PG8_WAIT_L(8); PG8_BAR; PG8_WAIT_L(0); PG8_MMA(0, 0, At, B0); PG8_BAR; PG8_SCHED;
            PG8_LDB(B1, 1, 1); PG8_STAGE(PG8_SB(1, 0), b3, voffB);
            PG8_BAR; PG8_WAIT_L(0); PG8_MMA(0, 1, At, B1); PG8_BAR;
            PG8_LDA(At, 1, 1); PG8_STAGE(PG8_SA(1, 0), a3, voffA);
            PG8_BAR; PG8_WAIT_L(0); PG8_MMA(1, 0, At, B0); PG8_BAR; PG8_SCHED;
            PG8_STAGE(PG8_SB(1, 1), b3 + hstep, voffB);
            PG8_WAIT_V(6); PG8_BAR; PG8_MMA(1, 1, At, B1); PG8_BAR;
            }
        }
        if constexpr (ALIGN_EPI) { if (wr == 0) PG8_BAR; }
        if constexpr (!Epi::AFTER_DRAIN) { E(acc, cur, wr, wc, fr, fq); S.done(cur); }
        if (!has_next) break;
#pragma unroll
        for (int a = 0; a < 2; ++a)
#pragma unroll
            for (int b = 0; b < 2; ++b)
#pragma unroll
                for (int m = 0; m < 4; ++m)
#pragma unroll
                    for (int n = 0; n < 2; ++n) acc[a][b][m][n] = (f32x4){0.f, 0.f, 0.f, 0.f};
        cur = nxt; cA = nA; cB = nB; kc = kn; ++ui;
        if constexpr (ALIGN_EPI) { if (wr == 1) PG8_BAR; }
    }
    PG8_WAIT_V(0);
    if constexpr (!ALIGN_EPI) { if (wr == 0) PG8_BAR; }
    PG8_BAR;
    if constexpr (Epi::AFTER_DRAIN) { E.fused(acc, cur, wr, wc, fr, fq, lds, wid, lane); S.done(cur); }
#undef PG8_SA
#undef PG8_SB
#undef PG8_STAGE
#undef PG8_LDA
#undef PG8_LDB
#undef PG8_MMA
#undef PG8_WAIT_V
#undef PG8_WAIT_L
#undef PG8_BAR
#undef PG8_SCHED
}
}
constexpr int DM = 4096, SEQ = 256, LSEQ = 4096, DEPTH = 2;
constexpr int MC = 8192, M = 16384;
constexpr int DIN = 11264;
constexpr int A_Q = 0, A_K = 1024, A_V = 2048, A_G = 3072, B_Q = 4096, B_K = 5120, B_V = 5376, B_G = 5632, C_U = 6656, C_G = 7680, D_Q = 8704, D_K = 9728, D_V = 9984, D_G = 10240;
constexpr float LN_EPS = 1e-5f, RMS_EPS = 1e-6f, DN_ALPHA = 1.41421356237f;
constexpr size_t MiB = 1u << 20;
constexpr size_t WS_CTL = 0, CTL_ZERO_BYTES = 1 * MiB;
constexpr size_t WS_ADA = 1 * MiB;
constexpr size_t WS_ROPE = 2 * MiB;
constexpr size_t WS_ROPEA = 2 * MiB + 32768;
constexpr size_t WS_LAM = 2 * MiB + 65536;
constexpr size_t WS_S5A = 3 * MiB;
constexpr size_t WS_S5BB = 4 * MiB;
constexpr size_t WS_CAK = 8 * MiB, WS_CAV = 10 * MiB, WS_CBK = 12 * MiB, WS_CBV = 12 * MiB + 512 * 1024, WS_CDK = 13 * MiB, WS_CDV = 13 * MiB + 512 * 1024;
constexpr size_t WS_WIN = 16 * MiB;
constexpr size_t WS_WOUT = 192 * MiB;
constexpr size_t WS_GLU = 256 * MiB;
constexpr size_t WS_HM = 264 * MiB;
constexpr size_t WS_PROJ = 392 * MiB;
constexpr size_t WS_YACT = 744 * MiB;
constexpr size_t WS_YD = 776 * MiB;
constexpr size_t WS_XR = 904 * MiB;
constexpr size_t WS_SEG = 1156 * MiB;
constexpr size_t WS_ASCR = 1160 * MiB;
constexpr size_t WS_END = 1192 * MiB;
constexpr int CW_BAR = 4096;
constexpr size_t O_AK = (size_t)M * DM, O_AV = O_AK + 16777216, O_BK = O_AV + 16777216, O_BV = O_BK + 4194304, O_DK = O_BV + 4194304, O_DV = O_DK + 4194304, O_CRE = O_DV + 4194304, O_CIM = O_CRE + 524288, O_END = O_CIM + 524288;
constexpr int RING_OFF = 0, RING_BYTES = 131072;
constexpr int LDSCTL_OFF = RING_BYTES, MISC_OFF = LDSCTL_OFF + 320;
constexpr int LDS_BYTES = 147456;
constexpr int NWAVES = 8, NTHREADS = 512;

#define GAS __attribute__((address_space(1)))
#define LAS __attribute__((address_space(3)))
typedef unsigned short bf16;
typedef unsigned v4u __attribute__((ext_vector_type(4)));
typedef unsigned v2u __attribute__((ext_vector_type(2)));
typedef float f32x4 __attribute__((ext_vector_type(4)));
typedef GAS unsigned gu32;
#define RLX_AGENT __ATOMIC_RELAXED, __HIP_MEMORY_SCOPE_AGENT
#define LDS_WAIT() asm volatile("s_waitcnt lgkmcnt(0)" ::: "memory")
__device__ __forceinline__ unsigned f2bf(float f) { unsigned u = __builtin_bit_cast(unsigned, f); return (u + 0x7fffu + ((u >> 16) & 1u)) >> 16; }
__device__ __forceinline__ unsigned pk2(float lo, float hi) { unsigned r; asm("v_cvt_pk_bf16_f32 %0, %1, %2" : "=v"(r) : "v"(lo), "v"(hi)); return r; }
__device__ __forceinline__ float bf2f(bf16 b) { return __uint_as_float(((unsigned)b) << 16); }
__device__ __forceinline__ float blo(unsigned w) { return __uint_as_float(w << 16); }
__device__ __forceinline__ float bhi(unsigned w) { return __uint_as_float(w & 0xffff0000u); }
__device__ __forceinline__ float siluf(float x) { return x * __builtin_amdgcn_rcpf(1.f + __expf(-x)); }
__device__ __forceinline__ float gelu_tanh(float x) { const float u = 0.7978845608028654f * (x + 0.044715f * x * x * x); const float e = __expf(2.f * u); const float t = 1.f - 2.f * __builtin_amdgcn_rcpf(e + 1.f); return 0.5f * x * (1.f + t); }
template <int CTRL> __device__ __forceinline__ float dpp_f(float v) { return __builtin_bit_cast(float, __builtin_amdgcn_update_dpp(0, __builtin_bit_cast(int, v), CTRL, 0xF, 0xF, true)); }
__device__ __forceinline__ float red4(float v) { v += dpp_f<0xB1>(v); v += dpp_f<0x4E>(v); return v; }
__device__ __forceinline__ float red8(float v) { v = red4(v); v += dpp_f<0x141>(v); return v; }
__device__ __forceinline__ float red16(float v) { v = red8(v); v += dpp_f<0x140>(v); return v; }
__device__ __forceinline__ float red32(float v) { v = red16(v); v += __builtin_bit_cast(float, __builtin_amdgcn_ds_swizzle(__builtin_bit_cast(int, v), 0x401F)); return v; }
__device__ __forceinline__ float wave_sum(float v) { v = red32(v); const auto rr = __builtin_amdgcn_permlane32_swap(__float_as_uint(v), __float_as_uint(v), false, false); return __uint_as_float(rr[0]) + __uint_as_float(rr[1]); }
#define XB_TMO      128
#define XB_XCNT(j)  (256  + 64 * (j))
#define XB_XSUB(j)  (1280 + 64 * (j))
#define XB_XGEN(j)  (2304 + 64 * (j))
#define XB_TOP      3328
#define XB_TOPGEN   3392
#define XCD_BAR_WORDS 3456
#define XB_SPIN_CAP (1u << 18)

__device__ __forceinline__ unsigned xb_ld(unsigned* p)              { return __hip_atomic_load(p, __ATOMIC_RELAXED, __HIP_MEMORY_SCOPE_AGENT); }
__device__ __forceinline__ unsigned xb_add(unsigned* p, unsigned v) { return __hip_atomic_fetch_add(p, v, __ATOMIC_RELAXED, __HIP_MEMORY_SCOPE_AGENT); }
__device__ __forceinline__ unsigned xb_xcc_id() { return (unsigned)__builtin_amdgcn_s_getreg((3 << 11) | 20) & 0xFu; }
#define XB_SPIN(cond, bar) do { unsigned _sp = 0; while (cond) { __builtin_amdgcn_s_sleep(1); \
    if ((++_sp & 255u) == 0u) { if (xb_ld(&(bar)[XB_TMO])) break; if (_sp > XB_SPIN_CAP) { atomicAdd(&(bar)[XB_TMO], 1u); break; } } } } while (0)

struct XcdBarrier {
    unsigned* bar; unsigned x;
    volatile LAS unsigned* st;
};

__device__ __forceinline__ XcdBarrier xcd_barrier_post(unsigned* bar, volatile LAS unsigned* st, bool leader) {
    XcdBarrier b; b.bar = bar; b.x = xb_xcc_id(); b.st = st;
    if (leader) (void)xb_add(&bar[XB_XCNT(b.x)], 1u);
    return b;
}
__device__ __forceinline__ void xcd_barrier_complete(unsigned* bar, unsigned x, unsigned& nloc, unsigned& nx) {
    const unsigned G = gridDim.x * gridDim.y * gridDim.z;
    unsigned sum, cnt, mine, sp = 0u;
    for (;;) {
        sum = 0u; cnt = 0u; mine = 0u;
#pragma unroll
        for (unsigned j = 0; j < 16; ++j) { const unsigned c = xb_ld(&bar[XB_XCNT(j)]); sum += c; cnt += (c > 0u) ? 1u : 0u; mine = (j == x) ? c : mine; }
        if (sum == G) break;
        __builtin_amdgcn_s_sleep(1);
        if ((++sp & 255u) == 0u) { if (xb_ld(&bar[XB_TMO])) break; if (sp > XB_SPIN_CAP) { atomicAdd(&bar[XB_TMO], 1u); break; } }
    }
    nloc = mine > 0u ? mine : 1u; nx = cnt > 0u ? cnt : 1u;
}

__device__ __forceinline__ void xcd_barrier(const XcdBarrier& b, bool leader) {
    asm volatile("s_waitcnt vmcnt(0)" ::: "memory");
    __syncthreads();
    if (leader) {
        unsigned* bar = b.bar;
        __builtin_amdgcn_s_waitcnt(0);
        unsigned nloc = b.st[0], nx = b.st[1];
        if (nloc == 0u) { xcd_barrier_complete(bar, b.x, nloc, nx); b.st[0] = nloc; b.st[1] = nx; }
        const unsigned old = xb_add(&bar[XB_XSUB(b.x)], 1u);
        const unsigned gen = old / nloc;
        if (old + 1u == (gen + 1u) * nloc) {
            __builtin_amdgcn_fence(__ATOMIC_RELEASE, "agent");
            asm volatile("s_waitcnt vmcnt(0)" ::: "memory");
            const unsigned og = xb_add(&bar[XB_TOP], 1u);
            const unsigned tg = og / nx;
            if (og + 1u == (tg + 1u) * nx) xb_add(&bar[XB_TOPGEN], 1u);
            else XB_SPIN(xb_ld(&bar[XB_TOPGEN]) == tg, bar);
            __builtin_amdgcn_fence(__ATOMIC_ACQUIRE, "agent");
            xb_add(&bar[XB_XGEN(b.x)], 1u);
            asm volatile("s_waitcnt vmcnt(0)" ::: "memory");
        } else {
            XB_SPIN(xb_ld(&bar[XB_XGEN(b.x)]) == gen, bar);
            __builtin_amdgcn_fence(__ATOMIC_ACQUIRE, "agent");
            asm volatile("s_waitcnt vmcnt(0)" ::: "memory");
        }
    }
    __syncthreads();
}
enum { I_XP = 0, I_XS, I_C, I_CAK, I_CAV, I_CBK, I_CBV, I_CDK, I_CDV, I_SRE, I_SIM, I_CCTX, I_WADA, I_BADA, I_WIN, I_WOUT, I_LNG, I_LNB, I_LQ1, I_LK1, I_LQ2, I_LK2, I_SUBG, I_QNG, I_KNG, I_SINK,
       I_CLRE, I_CLIM, I_CLDT, I_CBRE, I_CBIM, I_CCRE, I_CCIM, I_CD, I_GLUW, I_GLUB, N_IN };
struct Args { const float* in[N_IN]; float* out; unsigned char* ws; };
typedef const __attribute__((address_space(4))) Args CArgs;

struct TItem { const float* W; bf16* WT; int K, N, k0, n0; };
__device__ __forceinline__ void p0_item_dma(const TItem& t, LAS unsigned char* img, int lane) {
    const float* src = t.W + (size_t)(t.k0 + (lane >> 3)) * t.N + t.n0;
#pragma unroll
    for (int i = 0; i < 8; ++i) __builtin_amdgcn_global_load_lds((const unsigned*)(src + (size_t)(8 * i) * t.N + 4 * ((lane & 7) ^ i)), (LAS unsigned*)(img + i * 1024), 16, 0, 0);
}
__device__ __forceinline__ void p0_item_store(const TItem& t, const LAS unsigned char* img, int lane) {
    const int c = lane & 7; const LAS float* s = (const LAS float*)img + (8 * c) * 32;
#pragma unroll
    for (int j = 0; j < 4; ++j) { const int n = (lane >> 3) + 8 * j, o4 = (((n >> 2) ^ c) << 2) + (n & 3);
        v4u o; o.x = pk2(s[0 * 32 + o4], s[1 * 32 + o4]); o.y = pk2(s[2 * 32 + o4], s[3 * 32 + o4]); o.z = pk2(s[4 * 32 + o4], s[5 * 32 + o4]); o.w = pk2(s[6 * 32 + o4], s[7 * 32 + o4]);
        *(GAS v4u*)(t.WT + (size_t)(t.n0 + n) * t.K + t.k0 + 8 * c) = o; }
}
__device__ __forceinline__ void cvt_copy(const float* src, bf16* dst, size_t n8, size_t i0, size_t stride) {
    for (size_t i = i0; i < n8; i += stride) { const f32x4 a = *(const f32x4*)(src + 8 * i), b = *(const f32x4*)(src + 8 * i + 4);
        v4u o; o.x = pk2(a.x, a.y); o.y = pk2(a.z, a.w); o.z = pk2(b.x, b.y); o.w = pk2(b.z, b.w); *(v4u*)(dst + 8 * i) = o; }
}
__device__ __forceinline__ void p0_ada(CArgs& a, LAS unsigned char* lds, int wv) {
    int tid = tid_of(wv); asm volatile("" : "+v"(tid));
    unsigned char* ws = a.ws;
    {
        LAS float* S = (LAS float*)lds;
        LAS float* red = S + 3 * 4096;
        for (int i = tid; i < 3 * 4096; i += NTHREADS) { const int v = i >> 12, k = i & 4095; const float x = v == 0 ? a.in[I_CCTX][k] : a.in[I_C][(v - 1) * 4096 + k]; S[i] = siluf(x); }
        __syncthreads();
        const int q = tid % 24, ks = tid / 24;
        for (int grp = blockIdx.x; grp < 256; grp += gridDim.x) {
            const int l = grp >> 7, n0 = (grp & 127) * 96;
            f32x4 acc0 = {0.f, 0.f, 0.f, 0.f}, acc1 = acc0, acc2 = acc0;
            if (ks < 21) {
                const float* wp = a.in[I_WADA] + (size_t)l * 4096 * 12288 + n0 + 4 * q;
#pragma unroll 8
                for (int k = ks; k < 4096; k += 21) { const f32x4 w = *(const f32x4*)(wp + (size_t)k * 12288); acc0 += w * S[k]; acc1 += w * S[4096 + k]; acc2 += w * S[8192 + k]; }
                LAS float* r = red + (ks * 24 + q) * 12;
#pragma unroll
                for (int j = 0; j < 4; ++j) { r[j] = acc0[j]; r[4 + j] = acc1[j]; r[8 + j] = acc2[j]; }
            }
            __syncthreads();
            if (tid < 288) { const int v = tid / 96, c = tid % 96, qq = c >> 2, j = c & 3; float s = 0.f;
                for (int k2 = 0; k2 < 21; ++k2) s += red[(k2 * 24 + qq) * 12 + v * 4 + j];
                ((float*)(ws + WS_ADA))[(size_t)(l * 3 + v) * 12288 + n0 + c] = s + a.in[I_BADA][(size_t)l * 12288 + n0 + c]; }
            __syncthreads();
        }
    }
}
__device__ __forceinline__ void p0_prologue(CArgs& a, LAS unsigned char* lds, int wv) {
    int tid = tid_of(wv); asm volatile("" : "+v"(tid)); const int lane = tid & 63, wave = __builtin_amdgcn_readfirstlane(tid >> 6);
    const int gw = blockIdx.x * NWAVES + wave, NGW = gridDim.x * NWAVES;
    unsigned char* ws = a.ws;
    {
        LAS unsigned char* img = lds + wave * 16384;
        constexpr int I_IN = (DM / 64) * (DIN / 32), I_OUT = (DM / 64) * (DM / 32), I_GL = (1024 / 64) * (1024 / 32), I_L = I_IN + I_OUT + I_GL;
        auto decode = [&](int it) -> TItem { const int l = it / I_L; int r = it % I_L;
            if (r < I_IN) { const int nblk = DIN / 32; return TItem{a.in[I_WIN] + (size_t)l * DM * DIN, (bf16*)(ws + WS_WIN) + (size_t)l * DIN * DM, DM, DIN, 64 * (r / nblk), 32 * (r % nblk)}; } r -= I_IN;
            if (r < I_OUT) { const int nblk = DM / 32; return TItem{a.in[I_WOUT] + (size_t)l * DM * DM, (bf16*)(ws + WS_WOUT) + (size_t)l * DM * DM, DM, DM, 64 * (r / nblk), 32 * (r % nblk)}; } r -= I_OUT;
            const int nblk = 1024 / 32; return TItem{a.in[I_GLUW] + (size_t)l * 1024 * 1024, (bf16*)(ws + WS_GLU) + (size_t)l * 1024 * 1024, 1024, 1024, 64 * (r / nblk), 32 * (r % nblk)}; };
        int it = gw, par = 0;
        if (it < 2 * I_L) p0_item_dma(decode(it), img, lane);
        for (; it < 2 * I_L; it += NGW, par ^= 1) {
            const bool more = it + NGW < 2 * I_L;
            if (more) { p0_item_dma(decode(it + NGW), img + (par ^ 1) * 8192, lane); asm volatile("s_waitcnt vmcnt(8)" ::: "memory"); }
            else asm volatile("s_waitcnt vmcnt(0)" ::: "memory");
            p0_item_store(decode(it), img + par * 8192, lane);
            asm volatile("s_waitcnt lgkmcnt(0)" ::: "memory");
        }
    }
    {
        const size_t gt = (size_t)blockIdx.x * NTHREADS + tid, NGT = (size_t)gridDim.x * NTHREADS;
        cvt_copy(a.in[I_CAK], (bf16*)(ws + WS_CAK), 1048576 / 8, gt, NGT); cvt_copy(a.in[I_CAV], (bf16*)(ws + WS_CAV), 1048576 / 8, gt, NGT);
        cvt_copy(a.in[I_CBK], (bf16*)(ws + WS_CBK), 262144 / 8, gt, NGT);  cvt_copy(a.in[I_CBV], (bf16*)(ws + WS_CBV), 262144 / 8, gt, NGT);
        cvt_copy(a.in[I_CDK], (bf16*)(ws + WS_CDK), 262144 / 8, gt, NGT);  cvt_copy(a.in[I_CDV], (bf16*)(ws + WS_CDV), 262144 / 8, gt, NGT);
        float* rope = (float*)(ws + WS_ROPE);
        for (size_t i = gt; i < 2048; i += NGT) { const int pos = (int)(i >> 5), fi = (int)(i & 31); const float inv = exp2f(-(float)fi * (13.287712379549449f / 32.f)); const float ang = (float)pos * inv; rope[2 * i] = cosf(ang); rope[2 * i + 1] = sinf(ang); }
        { float* ropea = (float*)(ws + WS_ROPEA);
          for (size_t i = gt; i < 1024; i += NGT) { const int pos = (int)(i >> 4), fi = (int)(i & 15); const float inv = exp2f(-(float)fi * (13.287712379549449f / 16.f)); const float ang = (float)pos * inv; ropea[2 * i] = cosf(ang); ropea[2 * i + 1] = sinf(ang); } }
        float* sa_re = (float*)(ws + WS_S5A); float* sa_im = sa_re + 16384; float* sbb_re = (float*)(ws + WS_S5BB); float* sbb_im = sbb_re + 262144;
        for (size_t i = gt; i < 16384; i += NGT) {
            const float lr = a.in[I_CLRE][i], li = a.in[I_CLIM][i], dt = expf(a.in[I_CLDT][i >> 6]);
            const float mag = expf(lr * dt), th = li * dt, cs = cosf(th), sn = sinf(th);
            const float are = mag * cs, aim = mag * sn;
            const float sh = sinf(0.5f * th); const float nr = expm1f(lr * dt) * cs - 2.f * sh * sh;
            const float den = lr * lr + li * li;
            const float fre = (nr * lr + aim * li) / den, fim = (aim * lr - nr * li) / den;
            sa_re[i] = are; sa_im[i] = aim;
#pragma unroll
            for (int c = 0; c < 16; ++c) { const float br = a.in[I_CBRE][i * 16 + c], bi = a.in[I_CBIM][i * 16 + c]; sbb_re[i * 16 + c] = fre * br - fim * bi; sbb_im[i * 16 + c] = fre * bi + fim * br; }
        }
        if (gt < 2) { const int l = (int)gt; float s1 = 0.f, s2 = 0.f;
            for (int k = 0; k < 64; ++k) { s1 += a.in[I_LQ1][l * 64 + k] * a.in[I_LK1][l * 64 + k]; s2 += a.in[I_LQ2][l * 64 + k] * a.in[I_LK2][l * 64 + k]; }
            const float lam_init = l == 0 ? 0.2f : 0.35550906759f;
            ((float*)(ws + WS_LAM))[l] = expf(s1) - expf(s2) + lam_init; }
    }
}
__device__ __forceinline__ void row_norm16(f32x4 (&v)[16]) {
    float s = 0.f;
#pragma unroll
    for (int j = 0; j < 16; ++j) s += (v[j].x + v[j].y) + (v[j].z + v[j].w);
    const float mean = wave_sum(s) * (1.f / DM); float s2 = 0.f;
#pragma unroll
    for (int j = 0; j < 16; ++j) { v[j] = v[j] - mean; s2 += (v[j].x * v[j].x + v[j].y * v[j].y) + (v[j].z * v[j].z + v[j].w * v[j].w); }
    const float rstd = 1.f / sqrtf(wave_sum(s2) * (1.f / DM) + LN_EPS);
#pragma unroll
    for (int j = 0; j < 16; ++j) v[j] = v[j] * rstd;
}
__device__ __forceinline__ void row_ld_bf16(const bf16* row, int lane, f32x4 (&v)[16]) {
    const v2u* p = (const v2u*)row + lane;
#pragma unroll
    for (int j = 0; j < 16; ++j) { const v2u w = p[64 * j]; v[j] = (f32x4){blo(w.x), bhi(w.x), blo(w.y), bhi(w.y)}; }
}
__device__ __forceinline__ void row_st_bf16(bf16* row, int lane, const f32x4 (&v)[16]) {
    v2u* p = (v2u*)row + lane;
#pragma unroll
    for (int j = 0; j < 16; ++j) { v2u w; w.x = pk2(v[j].x, v[j].y); w.y = pk2(v[j].z, v[j].w); p[64 * j] = w; }
}
__device__ __forceinline__ void ln_mod_row(const float* xrow, const float* ada_v, bf16* hrow, int lane) {
    const f32x4* xr = (const f32x4*)xrow + lane; f32x4 v[16];
#pragma unroll
    for (int j = 0; j < 16; ++j) v[j] = xr[64 * j];
    row_norm16(v);
#pragma unroll
    for (int j = 0; j < 16; ++j) { const int col = 4 * (lane + 64 * j); v[j] = v[j] * (*(const f32x4*)(ada_v + 4096 + col) + 1.f) + *(const f32x4*)(ada_v + col); }
    row_st_bf16(hrow, lane, v);
}
__device__ __forceinline__ void ln_final_row(const bf16* xrow, const float* g, const float* b, float* orow, int lane) {
    f32x4 v[16]; row_ld_bf16(xrow, lane, v); row_norm16(v);
    f32x4* o = (f32x4*)orow + lane;
#pragma unroll
    for (int j = 0; j < 16; ++j) { const int col = 4 * (lane + 64 * j); o[64 * j] = v[j] * *(const f32x4*)(g + col) + *(const f32x4*)(b + col); }
}
__device__ __forceinline__ void ln_final_mod_row(const bf16* xrow, const float* g, const float* b, bf16* orow, const float* ada_v, bf16* hrow, int lane) {
    f32x4 v[16]; row_ld_bf16(xrow, lane, v); row_norm16(v);
#pragma unroll
    for (int j = 0; j < 16; ++j) { const int col = 4 * (lane + 64 * j); v[j] = v[j] * *(const f32x4*)(g + col) + *(const f32x4*)(b + col); }
    row_st_bf16(orow, lane, v);
    row_norm16(v);
#pragma unroll
    for (int j = 0; j < 16; ++j) { const int col = 4 * (lane + 64 * j); v[j] = v[j] * (*(const f32x4*)(ada_v + 4096 + col) + 1.f) + *(const f32x4*)(ada_v + col); }
    row_st_bf16(hrow, lane, v);
}
template <int NI> __device__ __forceinline__ void row_dma(const void* row, LAS unsigned char* buf, int lane) {
#pragma unroll
    for (int i = 0; i < NI; ++i) __builtin_amdgcn_global_load_lds((const unsigned*)((const char*)row + i * 1024 + lane * 16), (LAS unsigned*)(buf + i * 1024), 16, 0, 0);
}
__device__ __forceinline__ void row_lds_f32(const LAS unsigned char* buf, int lane, f32x4 (&r)[16]) { const LAS f32x4* p = (const LAS f32x4*)buf + lane;
#pragma unroll
    for (int j = 0; j < 16; ++j) r[j] = p[64 * j]; }
__device__ __forceinline__ void row_lds_bf16(const LAS unsigned char* buf, int lane, v2u (&r)[16]) { const LAS v2u* p = (const LAS v2u*)buf + lane;
#pragma unroll
    for (int j = 0; j < 16; ++j) r[j] = p[64 * j]; }
__device__ __forceinline__ void row_cvt16(const v2u (&r)[16], f32x4 (&v)[16]) {
#pragma unroll
    for (int j = 0; j < 16; ++j) v[j] = (f32x4){blo(r[j].x), bhi(r[j].x), blo(r[j].y), bhi(r[j].y)}; }
__device__ __forceinline__ void ln_mod_apply(f32x4 (&v)[16], const float* ada_v, bf16* hrow, int lane) {
    row_norm16(v);
#pragma unroll
    for (int j = 0; j < 16; ++j) { const int col = 4 * (lane + 64 * j); v[j] = v[j] * (*(const f32x4*)(ada_v + 4096 + col) + 1.f) + *(const f32x4*)(ada_v + col); }
    row_st_bf16(hrow, lane, v);
}
__device__ __forceinline__ void ln_final_apply(const v2u (&r)[16], const float* g, const float* b, float* orow, int lane) {
    f32x4 v[16]; row_cvt16(r, v); row_norm16(v);
    f32x4* o = (f32x4*)orow + lane;
#pragma unroll
    for (int j = 0; j < 16; ++j) { const int col = 4 * (lane + 64 * j); o[64 * j] = v[j] * *(const f32x4*)(g + col) + *(const f32x4*)(b + col); }
}
__device__ __forceinline__ void ln_final_mod_apply(const v2u (&r)[16], const float* g, const float* b, bf16* orow, const float* ada_v, bf16* hrow, int lane) {
    f32x4 v[16]; row_cvt16(r, v); row_norm16(v);
#pragma unroll
    for (int j = 0; j < 16; ++j) { const int col = 4 * (lane + 64 * j); v[j] = v[j] * *(const f32x4*)(g + col) + *(const f32x4*)(b + col); }
    row_st_bf16(orow, lane, v);
    row_norm16(v);
#pragma unroll
    for (int j = 0; j < 16; ++j) { const int col = 4 * (lane + 64 * j); v[j] = v[j] * (*(const f32x4*)(ada_v + 4096 + col) + 1.f) + *(const f32x4*)(ada_v + col); }
    row_st_bf16(hrow, lane, v);
}
__device__ __forceinline__ const float* x_row_in(CArgs& a, int m) { return m < MC ? a.in[I_XP] + (size_t)m * DM : a.in[I_XS] + (size_t)(m - MC) * DM; }
__device__ __forceinline__ int cond_of_row(int m) { return m < MC ? 0 : 1 + ((m - MC) >> 12); }

__device__ __forceinline__ void unpack8(const v4u w, float (&x)[8]) { x[0] = blo(w.x); x[1] = bhi(w.x); x[2] = blo(w.y); x[3] = bhi(w.y); x[4] = blo(w.z); x[5] = bhi(w.z); x[6] = blo(w.w); x[7] = bhi(w.w); }
__device__ __forceinline__ v4u pack8(const float (&x)[8]) { v4u w; w.x = pk2(x[0], x[1]); w.y = pk2(x[2], x[3]); w.z = pk2(x[4], x[5]); w.w = pk2(x[6], x[7]); return w; }
__device__ __forceinline__ void rope8(float (&x0)[8], float (&x1)[8], const float (&cs)[16]) {
#pragma unroll
    for (int t = 0; t < 8; ++t) { const float c = cs[2 * t], s = cs[2 * t + 1], y0 = x0[t] * c - x1[t] * s, y1 = x1[t] * c + x0[t] * s; x0[t] = y0; x1[t] = y1; }
}
__device__ __forceinline__ void load16f(const float* p, float (&v)[16]) {
#pragma unroll
    for (int q = 0; q < 4; ++q) { const f32x4 t = *(const f32x4*)(p + 4 * q); v[4 * q] = t.x; v[4 * q + 1] = t.y; v[4 * q + 2] = t.z; v[4 * q + 3] = t.w; }
}
__device__ __forceinline__ void cvt_out8(const bf16* src, float* dst) { const v4u w = *(const v4u*)src; *(f32x4*)dst = (f32x4){blo(w.x), bhi(w.x), blo(w.y), bhi(w.y)}; *(f32x4*)(dst + 4) = (f32x4){blo(w.z), bhi(w.z), blo(w.w), bhi(w.w)}; }
__device__ __forceinline__ void post_touch(CArgs& a, int m, int lane, LAS unsigned char* dummy) {
    const bf16* pr = (const bf16*)(a.ws + WS_PROJ) + (size_t)m * DIN;
    if (m < MC) { const int col = lane < 32 ? A_K + lane * 64 : lane < 56 ? B_Q + (lane - 32) * 64 : D_K + (lane - 56) * 64; __builtin_amdgcn_global_load_lds((const unsigned*)(pr + col), (LAS unsigned*)dummy, 4, 0, 0); }
    else { const int col = lane < 32 ? A_Q + lane * 64 : lane < 52 ? B_Q + (lane - 32) * 64 : D_Q + (lane - 52) * 64; __builtin_amdgcn_global_load_lds((const unsigned*)(pr + col), (LAS unsigned*)dummy, 4, 0, 0);
           }
}
__device__ __forceinline__ void post_row(CArgs& a, int l, int m, int lane) {
    bf16* pr = (bf16*)(a.ws + WS_PROJ) + (size_t)m * DIN;
    const float* qg = a.in[I_QNG] + l * 128; const float* kg = a.in[I_KNG] + l * 128;
    const int hh = lane >> 3, sub = lane & 7;
    if (m < MC) {
        const int b = m >> 8, n = m & 255; const size_t r1 = ((size_t)(b * 2 + l) * 256 + n);
        float* o_ak = a.out + O_AK + r1 * 1024; float* o_av = a.out + O_AV + r1 * 1024;
#pragma unroll
        for (int j = 0; j < 2; ++j) { const int e = (lane + 64 * j) * 8; cvt_out8(pr + A_K + e, o_ak + e); cvt_out8(pr + A_V + e, o_av + e); }
        float* o_bk = a.out + O_BK + r1 * 256; float* o_bv = a.out + O_BV + r1 * 256; float* o_dk = a.out + O_DK + r1 * 256; float* o_dv = a.out + O_DV + r1 * 256;
        if (lane < 32) { const int e = lane * 8; cvt_out8(pr + B_V + e, o_bv + e); cvt_out8(pr + D_K + e, o_dk + e); cvt_out8(pr + D_V + e, o_dv + e); }
#pragma unroll
        for (int pass = 0; pass < 2; ++pass) {
            const bool act = pass == 0 || lane < 16; const int hq = pass == 0 ? hh : (hh & 1);
            bf16* hp = pr + (pass == 0 ? B_Q : B_K) + hq * 128 + sub * 16; const float* g = (pass == 0 ? qg : kg) + sub * 16;
            float x0[8], x1[8], g16[16]; unpack8(*(const v4u*)hp, x0); unpack8(*(const v4u*)(hp + 8), x1); load16f(g, g16);
            float ss = 0.f;
#pragma unroll
            for (int t = 0; t < 8; ++t) ss += x0[t] * x0[t] + x1[t] * x1[t];
            ss = red8(ss);
            const float r = 1.f / sqrtf(ss * (1.f / 128.f) + RMS_EPS);
#pragma unroll
            for (int t = 0; t < 8; ++t) { x0[t] = x0[t] * r * g16[t]; x1[t] = x1[t] * r * g16[8 + t]; }
            if (act) { *(v4u*)hp = pack8(x0); *(v4u*)(hp + 8) = pack8(x1);
                if (pass == 1) { float* ob = o_bk + hq * 128 + sub * 16; *(f32x4*)ob = (f32x4){x0[0], x0[1], x0[2], x0[3]}; *(f32x4*)(ob + 4) = (f32x4){x0[4], x0[5], x0[6], x0[7]};
                    *(f32x4*)(ob + 8) = (f32x4){x1[0], x1[1], x1[2], x1[3]}; *(f32x4*)(ob + 12) = (f32x4){x1[4], x1[5], x1[6], x1[7]}; } }
        }
    } else {
        const int n = (m - MC) & 4095, rr = n >> 6, cc = n & 63;
        { const int ha = lane >> 2, sa = lane & 3, half = sa >> 1, j = sa & 1; float cs[16]; load16f((const float*)(a.ws + WS_ROPEA) + ((half ? cc : rr) * 16 + j * 8) * 2, cs);
#pragma unroll
            for (int t2 = 0; t2 < 2; ++t2) { bf16* hp = pr + (t2 ? A_K : A_Q) + ha * 64 + half * 32 + j * 8; float x0[8], x1[8]; unpack8(*(const v4u*)hp, x0); unpack8(*(const v4u*)(hp + 16), x1);
                rope8(x0, x1, cs); *(v4u*)hp = pack8(x0); *(v4u*)(hp + 16) = pack8(x1); } }
        { const int half = sub >> 2, j = sub & 3; float cs[16]; load16f((const float*)(a.ws + WS_ROPE) + ((half ? cc : rr) * 32 + j * 8) * 2, cs);
#pragma unroll
            for (int pass = 0; pass < 3; ++pass) {
                const bool act = pass < 2 || lane < 32; const bool isB = pass == 0 || (pass == 2 && lane < 16); const int hq = pass < 2 ? hh : (hh & 1);
                bf16* hp = pr + (pass == 0 ? B_Q : pass == 1 ? D_Q : (lane < 16 ? B_K : D_K)) + hq * 128 + half * 64 + j * 8;
                const float* g = (pass == 0 ? qg : kg) + half * 64 + j * 8;
                float x0[8], x1[8]; unpack8(*(const v4u*)hp, x0); unpack8(*(const v4u*)(hp + 32), x1);
                float ss = 0.f;
#pragma unroll
                for (int t = 0; t < 8; ++t) ss += x0[t] * x0[t] + x1[t] * x1[t];
                ss = red8(ss);
                if (isB) { const float r = 1.f / sqrtf(ss * (1.f / 128.f) + RMS_EPS); const f32x4 ga = *(const f32x4*)g, gb = *(const f32x4*)(g + 4), gc = *(const f32x4*)(g + 32), gd = *(const f32x4*)(g + 36);
                    const float g0[8] = {ga.x, ga.y, ga.z, ga.w, gb.x, gb.y, gb.z, gb.w}, g1[8] = {gc.x, gc.y, gc.z, gc.w, gd.x, gd.y, gd.z, gd.w};
#pragma unroll
                    for (int t = 0; t < 8; ++t) { x0[t] = x0[t] * r * g0[t]; x1[t] = x1[t] * r * g1[t]; } }
                rope8(x0, x1, cs);
                if (act) { *(v4u*)hp = pack8(x0); *(v4u*)(hp + 32) = pack8(x1); }
            } }
    }
}
namespace fa {
using bf16x8 = __attribute__((ext_vector_type(8))) short;
using s16x4  = __attribute__((ext_vector_type(4))) short;
using f32x16 = __attribute__((ext_vector_type(16))) float;
using u32x4  = __attribute__((ext_vector_type(4))) unsigned;
typedef LAS char* lptr;
constexpr int KVBLK = 64;
constexpr int SHM_V = 64 * 128 * 2, SHM_K = 64 * 128 * 2, SHM_ATTN = 2 * SHM_V + 2 * SHM_K + 8 * 64 * 4;
constexpr float THR = 8.f;
#define FA_KSWZ(row, colB) ((row) * 256 + ((colB) ^ (((row) & 7) << 4)))
#define FA_KSWZ64(row, colB) ((row) * 128 + ((colB) ^ ((((row) >> 1) & 7) << 4)))
#define FA_SBAR() __builtin_amdgcn_sched_barrier(0)
__device__ __forceinline__ int crow(int r, int hi) { return (r & 3) + 8 * (r >> 2) + 4 * hi; }
__device__ __forceinline__ unsigned cvtpk(float lo, float hi) { unsigned r; asm volatile("v_cvt_pk_bf16_f32 %0, %1, %2" : "=v"(r) : "v"(lo), "v"(hi)); return r; }
template <int DQK> struct Sc { static constexpr float SCALE = DQK == 128 ? 0.088388347648318440f : 0.125f; };

template <int DQK>
__device__ __forceinline__ void partialSM(f32x16& p0, f32x16& p1, float& m_reg, float& mn, float& alpha) {
  constexpr float SCALE = Sc<DQK>::SCALE, C = SCALE * 1.4426950408889634f;
  float pmax = p0[0];
#pragma unroll
  for (int r = 1; r < 16; ++r) pmax = fmaxf(pmax, p0[r]);
#pragma unroll
  for (int r = 0; r < 16; ++r) pmax = fmaxf(pmax, p1[r]);
  { auto rr = __builtin_amdgcn_permlane32_swap(__float_as_uint(pmax), __float_as_uint(pmax), false, false);
    pmax = fmaxf(__uint_as_float(rr[0]), __uint_as_float(rr[1])); }
  if (__builtin_expect(__all(pmax - m_reg <= THR / SCALE), 1)) { mn = m_reg; alpha = 1.f; }
  else { mn = fmaxf(m_reg, pmax); alpha = __builtin_amdgcn_exp2f((m_reg - mn) * C); m_reg = mn; }
  const float mnC = -mn * C;
#pragma unroll
  for (int r = 0; r < 16; ++r) p0[r] = fmaf(p0[r], C, mnC);
#pragma unroll
  for (int r = 0; r < 16; ++r) p1[r] = fmaf(p1[r], C, mnC);
#pragma unroll
  for (int r = 0; r < 16; ++r) p0[r] = __builtin_amdgcn_exp2f(p0[r]);
}
__device__ __forceinline__ void finishSM(f32x16& p0, f32x16& p1, float alpha, float& l_reg, bf16x8& pa0, bf16x8& pa1, bf16x8& pa2, bf16x8& pa3) {
#pragma unroll
  for (int r = 0; r < 16; ++r) p1[r] = __builtin_amdgcn_exp2f(p1[r]);
  float ps = 0;
#pragma unroll
  for (int r = 0; r < 16; ++r) ps += p0[r];
#pragma unroll
  for (int r = 0; r < 16; ++r) ps += p1[r];
  { auto rr = __builtin_amdgcn_permlane32_swap(__float_as_uint(ps), __float_as_uint(ps), false, false);
    ps = __uint_as_float(rr[0]) + __uint_as_float(rr[1]); }
  l_reg = l_reg * alpha + ps;
#define FA_PK4(P, BASE, OUT) do { unsigned a0 = cvtpk(P[BASE + 0], P[BASE + 1]), a1 = cvtpk(P[BASE + 2], P[BASE + 3]);   \
    unsigned b0 = cvtpk(P[BASE + 4], P[BASE + 5]), b1 = cvtpk(P[BASE + 6], P[BASE + 7]);                              \
    auto r0 = __builtin_amdgcn_permlane32_swap(a0, b0, false, false); auto r1 = __builtin_amdgcn_permlane32_swap(a1, b1, false, false); \
    u32x4 w = {r0[0], r1[0], r0[1], r1[1]}; OUT = __builtin_bit_cast(bf16x8, w); } while (0)
  FA_PK4(p0, 0, pa0); FA_PK4(p0, 8, pa1); FA_PK4(p1, 0, pa2); FA_PK4(p1, 8, pa3);
#undef FA_PK4
}
template <int DQK>
__device__ __forceinline__ void qkt(f32x16& p0, f32x16& p1, lptr Ks, const bf16x8* qr, int r32, int hi) {
  p0 = f32x16{}; p1 = f32x16{};
#pragma unroll
  for (int d0 = 0; d0 < DQK / 16; ++d0) { const int cb = (d0 * 16 + hi * 8) * 2;
    const bf16x8 b0 = *(const LAS bf16x8*)(Ks + (DQK == 128 ? FA_KSWZ(r32, cb) : FA_KSWZ64(r32, cb)));
    const bf16x8 b1 = *(const LAS bf16x8*)(Ks + (DQK == 128 ? FA_KSWZ(32 + r32, cb) : FA_KSWZ64(32 + r32, cb)));
    p0 = __builtin_amdgcn_mfma_f32_32x32x16_bf16(b0, qr[d0], p0, 0, 0, 0);
    p1 = __builtin_amdgcn_mfma_f32_32x32x16_bf16(b1, qr[d0], p1, 0, 0, 0); }
}
__device__ __forceinline__ void band_mask(f32x16& p0, f32x16& p1, int kpos0, int qpos, int hi) {
#pragma unroll
  for (int r = 0; r < 16; ++r) { const int d0 = kpos0 + crow(r, hi) - qpos, d1 = d0 + 32;
    p0[r] = (d0 > 128 || d0 < -128) ? -1e30f : p0[r]; p1[r] = (d1 > 128 || d1 < -128) ? -1e30f : p1[r]; }
}
__device__ __forceinline__ int v_st(int k, int c) { const int kk = (k & ~0xC) | ((k & 4) << 1) | ((k & 8) >> 1); return ((kk >> 3) * 4 + (c >> 5)) * 512 + ((kk & 7) * 32 + (c & 31)) * 2; }
__device__ __forceinline__ int v_rd_base(int lane) { return ((lane & 3) << 3) | (((lane >> 2) & 3) << 6) | (((lane >> 4) & 1) << 5) | (((lane >> 5) & 1) << 8); }
constexpr int v_rd_off(int d0, int ks, int half) { return d0 * 512 + ks * 4096 + half * 2048; }
template <int OFF> __device__ __forceinline__ s16x4 tr_read(int vb) {
  s16x4 r; asm volatile("ds_read_b64_tr_b16 %0, %1 offset:%2" : "=&v"(r) : "v"(vb), "i"(OFF) : "memory"); return r;
}
template <int D0> __device__ __forceinline__ void pv_one(f32x16& od, int vb, bf16x8 pa0, bf16x8 pa1, bf16x8 pa2, bf16x8 pa3) {
  const s16x4 l0 = tr_read<v_rd_off(D0, 0, 0)>(vb), h0 = tr_read<v_rd_off(D0, 0, 1)>(vb), l1 = tr_read<v_rd_off(D0, 1, 0)>(vb), h1 = tr_read<v_rd_off(D0, 1, 1)>(vb);
  const s16x4 l2 = tr_read<v_rd_off(D0, 2, 0)>(vb), h2 = tr_read<v_rd_off(D0, 2, 1)>(vb), l3 = tr_read<v_rd_off(D0, 3, 0)>(vb), h3 = tr_read<v_rd_off(D0, 3, 1)>(vb);
  asm volatile("s_waitcnt lgkmcnt(0)" ::: "memory"); FA_SBAR();
#define FA_PK(L, H) (bf16x8){L[0], L[1], L[2], L[3], H[0], H[1], H[2], H[3]}
  od = __builtin_amdgcn_mfma_f32_32x32x16_bf16(pa0, FA_PK(l0, h0), od, 0, 0, 0);
  od = __builtin_amdgcn_mfma_f32_32x32x16_bf16(pa1, FA_PK(l1, h1), od, 0, 0, 0);
  od = __builtin_amdgcn_mfma_f32_32x32x16_bf16(pa2, FA_PK(l2, h2), od, 0, 0, 0);
  od = __builtin_amdgcn_mfma_f32_32x32x16_bf16(pa3, FA_PK(l3, h3), od, 0, 0, 0);
#undef FA_PK
}
template <int DA, int DB> __device__ __forceinline__ void pv_two(f32x16& oa, f32x16& ob, int vb, bf16x8 pa0, bf16x8 pa1, bf16x8 pa2, bf16x8 pa3) {
  const s16x4 al0 = tr_read<v_rd_off(DA, 0, 0)>(vb), ah0 = tr_read<v_rd_off(DA, 0, 1)>(vb), bl0 = tr_read<v_rd_off(DB, 0, 0)>(vb), bh0 = tr_read<v_rd_off(DB, 0, 1)>(vb);
  const s16x4 al1 = tr_read<v_rd_off(DA, 1, 0)>(vb), ah1 = tr_read<v_rd_off(DA, 1, 1)>(vb), bl1 = tr_read<v_rd_off(DB, 1, 0)>(vb), bh1 = tr_read<v_rd_off(DB, 1, 1)>(vb);
  const s16x4 al2 = tr_read<v_rd_off(DA, 2, 0)>(vb), ah2 = tr_read<v_rd_off(DA, 2, 1)>(vb), bl2 = tr_read<v_rd_off(DB, 2, 0)>(vb), bh2 = tr_read<v_rd_off(DB, 2, 1)>(vb);
  const s16x4 al3 = tr_read<v_rd_off(DA, 3, 0)>(vb), ah3 = tr_read<v_rd_off(DA, 3, 1)>(vb), bl3 = tr_read<v_rd_off(DB, 3, 0)>(vb), bh3 = tr_read<v_rd_off(DB, 3, 1)>(vb);
  asm volatile("s_waitcnt lgkmcnt(0)" ::: "memory"); FA_SBAR();
#define FA_PK(L, H) (bf16x8){L[0], L[1], L[2], L[3], H[0], H[1], H[2], H[3]}
  oa = __builtin_amdgcn_mfma_f32_32x32x16_bf16(pa0, FA_PK(al0, ah0), oa, 0, 0, 0); ob = __builtin_amdgcn_mfma_f32_32x32x16_bf16(pa0, FA_PK(bl0, bh0), ob, 0, 0, 0);
  oa = __builtin_amdgcn_mfma_f32_32x32x16_bf16(pa1, FA_PK(al1, ah1), oa, 0, 0, 0); ob = __builtin_amdgcn_mfma_f32_32x32x16_bf16(pa1, FA_PK(bl1, bh1), ob, 0, 0, 0);
  oa = __builtin_amdgcn_mfma_f32_32x32x16_bf16(pa2, FA_PK(al2, ah2), oa, 0, 0, 0); ob = __builtin_amdgcn_mfma_f32_32x32x16_bf16(pa2, FA_PK(bl2, bh2), ob, 0, 0, 0);
  oa = __builtin_amdgcn_mfma_f32_32x32x16_bf16(pa3, FA_PK(al3, ah3), oa, 0, 0, 0); ob = __builtin_amdgcn_mfma_f32_32x32x16_bf16(pa3, FA_PK(bl3, bh3), ob, 0, 0, 0);
#undef FA_PK
}
__device__ __forceinline__ void pv_d0(f32x16* o, int vb, bf16x8 pa0, bf16x8 pa1, bf16x8 pa2, bf16x8 pa3) {
  pv_two<0, 1>(o[0], o[1], vb, pa0, pa1, pa2, pa3); pv_two<2, 3>(o[2], o[3], vb, pa0, pa1, pa2, pa3);
}

struct Src { const bf16* K; const bf16* V; int ld; };
template <int DQK, bool BAND>
__device__ __forceinline__ void core(const bf16* __restrict__ Qb, int ldq, const Src A, int NTA, const Src B, int NT, int q0, int kb0, lptr lds, f32x16 (&o)[4], float& m_out, float& l_out, int wv) {
  int tid = tid_of(wv); asm volatile("" : "+v"(tid));
  const int wid = tid >> 6, lane = tid & 63, r32 = lane & 31, hi = lane >> 5;
  lptr V_lds = lds; lptr K_lds = lds + 2 * SHM_V;
  LAS float* al_l = (LAS float*)(lds + 2 * SHM_V + 2 * SHM_K) + wid * 64 + 32;
  float m_reg = -1e30f, l_reg = 0.f;
#pragma unroll
  for (int d = 0; d < 4; ++d) o[d] = f32x16{};
  bf16x8 qr[DQK / 16];
  { const bf16* Qw = Qb + (size_t)(wid * 32 + r32) * ldq + hi * 8;
#pragma unroll
    for (int d0 = 0; d0 < DQK / 16; ++d0) qr[d0] = *(const bf16x8*)(Qw + d0 * 16); }
  const int qpos = q0 + wid * 32 + r32, qmin = q0 + wid * 32;
  const int sr = tid >> 4, sc = (tid & 15) * 8, vst0 = v_st(sr, sc), vst1 = v_st(32 + sr, sc);
  const int k64r = tid >> 3, k64c = (tid & 7) * 8;
  const int vb0 = (int)(uintptr_t)V_lds + v_rd_base(lane);
  struct { bf16x8 vs0, vs1, ks0, ks1; } st[2];
#define FA_SLOAD(i, t) do { const bool inA_ = (t) < NTA; const bf16* Kp_ = inA_ ? A.K : B.K; const bf16* Vp_ = inA_ ? A.V : B.V; const int ld_ = inA_ ? A.ld : B.ld; const int k0_ = (inA_ ? (t) : (t) - NTA) * KVBLK; \
    st[i].vs0 = *(const bf16x8*)(Vp_ + (size_t)(k0_ + sr) * ld_ + sc); st[i].vs1 = *(const bf16x8*)(Vp_ + (size_t)(k0_ + 32 + sr) * ld_ + sc); \
    if constexpr (DQK == 128) { st[i].ks0 = *(const bf16x8*)(Kp_ + (size_t)(k0_ + sr) * ld_ + sc); st[i].ks1 = *(const bf16x8*)(Kp_ + (size_t)(k0_ + 32 + sr) * ld_ + sc); } \
    else { st[i].ks0 = *(const bf16x8*)(Kp_ + (size_t)(k0_ + k64r) * ld_ + k64c); } } while (0)
#define FA_SWRITE(b, i) do { *(LAS bf16x8*)(V_lds + (b) * SHM_V + vst0) = st[i].vs0; *(LAS bf16x8*)(V_lds + (b) * SHM_V + vst1) = st[i].vs1; \
    if constexpr (DQK == 128) { const int kc = sc * 2; *(LAS bf16x8*)(K_lds + (b) * SHM_K + FA_KSWZ(sr, kc)) = st[i].ks0; *(LAS bf16x8*)(K_lds + (b) * SHM_K + FA_KSWZ(32 + sr, kc)) = st[i].ks1; } \
    else { *(LAS bf16x8*)(K_lds + (b) * SHM_K + FA_KSWZ64(k64r, k64c * 2)) = st[i].ks0; } } while (0)
#define FA_SWAIT() do { if constexpr (DQK == 128) asm volatile("s_waitcnt vmcnt(4)" ::: "memory"); else asm volatile("s_waitcnt vmcnt(3)" ::: "memory"); } while (0)
#define FA_RESC(a) do { if (__any((a) < 1.f)) { if (hi == 0) al_l[r32] = (a); asm volatile("s_waitcnt lgkmcnt(0)" ::: "memory"); \
    _Pragma("unroll") for (int d = 0; d < 4; ++d) _Pragma("unroll") for (int r = 0; r < 16; ++r) o[d][r] *= al_l[crow(r, hi)]; } } while (0)
#define FA_MASK(P0, P1, t) do { if constexpr (BAND) { if ((t) >= NTA) { const int kp0_ = kb0 + ((t) - NTA) * KVBLK; \
    if (!(kp0_ >= qmin + 31 - 128 && kp0_ + 63 <= qmin + 128)) band_mask(P0, P1, kp0_, qpos, hi); } } } while (0)
  f32x16 pA0, pA1, pB0, pB1; float mnA, mnB, alA, alB; bf16x8 pa0, pa1, pa2, pa3;
  FA_SLOAD(0, 0); FA_SLOAD(1, 1);
  FA_SWAIT(); FA_SWRITE(0, 0); __syncthreads();
  if (2 < NT) FA_SLOAD(0, 2);
  qkt<DQK>(pA0, pA1, K_lds, qr, r32, hi); FA_MASK(pA0, pA1, 0); partialSM<DQK>(pA0, pA1, m_reg, mnA, alA);
  FA_SWAIT(); FA_SWRITE(1, 1); __syncthreads();
  for (int j = 1; j + 1 < NT; j += 2) {
    FA_SBAR(); qkt<DQK>(pB0, pB1, K_lds + SHM_K, qr, r32, hi);
    finishSM(pA0, pA1, alA, l_reg, pa0, pa1, pa2, pa3); FA_SBAR();
    FA_SLOAD(1, j + 2); FA_SBAR();
    pv_d0(o, vb0, pa0, pa1, pa2, pa3); FA_MASK(pB0, pB1, j); partialSM<DQK>(pB0, pB1, m_reg, mnB, alB);
    __syncthreads(); FA_SWAIT(); FA_SWRITE(0, 0);
    FA_RESC(alB); __syncthreads();
    FA_SBAR(); qkt<DQK>(pA0, pA1, K_lds, qr, r32, hi);
    finishSM(pB0, pB1, alB, l_reg, pa0, pa1, pa2, pa3); FA_SBAR();
    if (j + 3 < NT) FA_SLOAD(0, j + 3); FA_SBAR();
    pv_d0(o, vb0 + SHM_V, pa0, pa1, pa2, pa3); FA_MASK(pA0, pA1, j + 1); partialSM<DQK>(pA0, pA1, m_reg, mnA, alA);
    __syncthreads(); FA_SWAIT(); FA_SWRITE(1, 1);
    FA_RESC(alA); __syncthreads();
  }
  FA_SBAR(); qkt<DQK>(pB0, pB1, K_lds + SHM_K, qr, r32, hi);
  finishSM(pA0, pA1, alA, l_reg, pa0, pa1, pa2, pa3); FA_SBAR();
  pv_d0(o, vb0, pa0, pa1, pa2, pa3); FA_MASK(pB0, pB1, NT - 1); partialSM<DQK>(pB0, pB1, m_reg, mnB, alB);
  __syncthreads(); FA_RESC(alB);
  finishSM(pB0, pB1, alB, l_reg, pa0, pa1, pa2, pa3); FA_SBAR();
  pv_d0(o, vb0 + SHM_V, pa0, pa1, pa2, pa3);
  m_out = m_reg; l_out = l_reg;
#undef FA_SLOAD
#undef FA_SWRITE
#undef FA_SWAIT
#undef FA_RESC
#undef FA_MASK
}
constexpr int CTX_SCR = 131072 + 1024;
template <int DQK, bool BAND>
__device__ __forceinline__ void core3(const bf16* __restrict__ Qb, int ldq, const Src A, int NTA, const Src B, int NT, int q0, int kb0, lptr lds, f32x16 (&o)[4], float& m_out, float& l_out, int wv) {
  int tid = tid_of(wv); asm volatile("" : "+v"(tid));
  const int wid = tid >> 6, lane = tid & 63, r32 = lane & 31, hi = lane >> 5;
  lptr V_lds = lds; lptr K_lds = lds + 3 * SHM_V;
  LAS float* al_l = (LAS float*)(lds + CTX_SCR) + wid * 64 + 32;
  float m_reg = -1e30f, l_reg = 0.f;
#pragma unroll
  for (int d = 0; d < 4; ++d) o[d] = f32x16{};
  bf16x8 qr[DQK / 16];
  { const bf16* Qw = Qb + (size_t)(wid * 32 + r32) * ldq + hi * 8;
#pragma unroll
    for (int d0 = 0; d0 < DQK / 16; ++d0) qr[d0] = *(const bf16x8*)(Qw + d0 * 16); }
  const int qpos = q0 + wid * 32 + r32, qmin = q0 + wid * 32;
  const int sr = tid >> 4, sc = (tid & 15) * 8, vst0 = v_st(sr, sc), vst1 = v_st(32 + sr, sc);
  const int k64r = tid >> 3, k64c = (tid & 7) * 8;
  const int vb0 = (int)(uintptr_t)V_lds + v_rd_base(lane);
  struct { bf16x8 vs0, vs1, ks0, ks1; } st[2];
#define C3_SLOAD(i, t) do { const bool inA_ = (t) < NTA; const bf16* Kp_ = inA_ ? A.K : B.K; const bf16* Vp_ = inA_ ? A.V : B.V; const int ld_ = inA_ ? A.ld : B.ld; const int k0_ = (inA_ ? (t) : (t) - NTA) * KVBLK; \
    st[i].vs0 = *(const bf16x8*)(Vp_ + (size_t)(k0_ + sr) * ld_ + sc); st[i].vs1 = *(const bf16x8*)(Vp_ + (size_t)(k0_ + 32 + sr) * ld_ + sc); \
    if constexpr (DQK == 128) { st[i].ks0 = *(const bf16x8*)(Kp_ + (size_t)(k0_ + sr) * ld_ + sc); st[i].ks1 = *(const bf16x8*)(Kp_ + (size_t)(k0_ + 32 + sr) * ld_ + sc); } \
    else { st[i].ks0 = *(const bf16x8*)(Kp_ + (size_t)(k0_ + k64r) * ld_ + k64c); } } while (0)
#define C3_SWRITE(b, i) do { *(LAS bf16x8*)(V_lds + (b) * SHM_V + vst0) = st[i].vs0; *(LAS bf16x8*)(V_lds + (b) * SHM_V + vst1) = st[i].vs1; \
    if constexpr (DQK == 128) { const int kc = sc * 2; *(LAS bf16x8*)(K_lds + (b) * SHM_K + FA_KSWZ(sr, kc)) = st[i].ks0; *(LAS bf16x8*)(K_lds + (b) * SHM_K + FA_KSWZ(32 + sr, kc)) = st[i].ks1; } \
    else { *(LAS bf16x8*)(K_lds + (b) * SHM_K + FA_KSWZ64(k64r, k64c * 2)) = st[i].ks0; } } while (0)
#define C3_SWAIT() do { if constexpr (DQK == 128) asm volatile("s_waitcnt vmcnt(4)" ::: "memory"); else asm volatile("s_waitcnt vmcnt(3)" ::: "memory"); } while (0)
#define C3_RESC(a) do { if (__any((a) < 1.f)) { if (hi == 0) al_l[r32] = (a); asm volatile("s_waitcnt lgkmcnt(0)" ::: "memory"); \
    _Pragma("unroll") for (int d = 0; d < 4; ++d) _Pragma("unroll") for (int r = 0; r < 16; ++r) o[d][r] *= al_l[crow(r, hi)]; } } while (0)
#define C3_MASK(P0, P1, t) do { if constexpr (BAND) { if ((t) >= NTA) { const int kp0_ = kb0 + ((t) - NTA) * KVBLK; \
    if (!(kp0_ >= qmin + 31 - 128 && kp0_ + 63 <= qmin + 128)) band_mask(P0, P1, kp0_, qpos, hi); } } } while (0)
#define C3_ITER(t, PX0, PX1, mnX, alX, PY0, PY1, alY) do { \
    FA_SBAR(); qkt<DQK>(PX0, PX1, K_lds + bt * SHM_K, qr, r32, hi); finishSM(PY0, PY1, alY, l_reg, pa0, pa1, pa2, pa3); FA_SBAR(); \
    if ((t) + 2 < NT) { if ((t) & 1) C3_SLOAD(1, (t) + 2); else C3_SLOAD(0, (t) + 2); } FA_SBAR(); \
    pv_d0(o, vb0 + bp * SHM_V, pa0, pa1, pa2, pa3); C3_MASK(PX0, PX1, (t)); partialSM<DQK>(PX0, PX1, m_reg, mnX, alX); \
    if ((t) + 1 < NT) { C3_SWAIT(); if ((t) & 1) C3_SWRITE(bn, 0); else C3_SWRITE(bn, 1); } \
    C3_RESC(alX); \
    bp = bt; bt = bn; bn = bn == 2 ? 0 : bn + 1; } while (0)
  f32x16 pA0, pA1, pB0, pB1; float mnA, mnB, alA, alB; bf16x8 pa0, pa1, pa2, pa3;
  C3_SLOAD(0, 0); C3_SLOAD(1, 1);
  C3_SWAIT(); C3_SWRITE(0, 0); __syncthreads();
  if (2 < NT) C3_SLOAD(0, 2);
  qkt<DQK>(pA0, pA1, K_lds, qr, r32, hi); C3_MASK(pA0, pA1, 0); partialSM<DQK>(pA0, pA1, m_reg, mnA, alA);
  C3_SWAIT(); C3_SWRITE(1, 1); __syncthreads();
  int bt = 1, bp = 0, bn = 2;
  for (int t = 1; t + 2 < NT; t += 2) {
    C3_ITER(t, pB0, pB1, mnB, alB, pA0, pA1, alA); __syncthreads();
    C3_ITER(t + 1, pA0, pA1, mnA, alA, pB0, pB1, alB); __syncthreads();
  }
  C3_ITER(NT - 1, pB0, pB1, mnB, alB, pA0, pA1, alA);
  finishSM(pB0, pB1, alB, l_reg, pa0, pa1, pa2, pa3); FA_SBAR();
  pv_d0(o, vb0 + bp * SHM_V, pa0, pa1, pa2, pa3);
  m_out = m_reg; l_out = l_reg;
#undef C3_SLOAD
#undef C3_SWRITE
#undef C3_SWAIT
#undef C3_RESC
#undef C3_MASK
#undef C3_ITER
}
template <int DQK>
__device__ __forceinline__ void core_ctx(const bf16* __restrict__ Qb, int ldq, const Src A, lptr lds, f32x16 (&o)[4], float& m_out, float& l_out, int wv) {
  int tid = tid_of(wv); asm volatile("" : "+v"(tid));
  const int wid = tid >> 6, lane = tid & 63, r32 = lane & 31, hi = lane >> 5;
  lptr V_lds = lds; lptr K_lds = lds + 4 * SHM_V;
  LAS float* al_l = (LAS float*)(lds + CTX_SCR) + wid * 64 + 32;
  float m_reg = -1e30f, l_reg = 0.f;
  bf16x8 qr[DQK / 16];
  { const bf16* Qw = Qb + (size_t)(wid * 32 + r32) * ldq + hi * 8;
#pragma unroll
    for (int d0 = 0; d0 < DQK / 16; ++d0) qr[d0] = *(const bf16x8*)(Qw + d0 * 16); }
  { const int sr = tid >> 4, sc = (tid & 15) * 8, vst0 = v_st(sr, sc), vst1 = v_st(32 + sr, sc); const int k64r = tid >> 3, k64c = (tid & 7) * 8;
    bf16x8 vs[4][2], ks[4][2];
#pragma unroll
    for (int t = 0; t < 4; ++t) { vs[t][0] = *(const bf16x8*)(A.V + (size_t)(t * 64 + sr) * A.ld + sc); vs[t][1] = *(const bf16x8*)(A.V + (size_t)(t * 64 + 32 + sr) * A.ld + sc);
      if constexpr (DQK == 128) { ks[t][0] = *(const bf16x8*)(A.K + (size_t)(t * 64 + sr) * A.ld + sc); ks[t][1] = *(const bf16x8*)(A.K + (size_t)(t * 64 + 32 + sr) * A.ld + sc); }
      else ks[t][0] = *(const bf16x8*)(A.K + (size_t)(t * 64 + k64r) * A.ld + k64c); }
#pragma unroll
    for (int t = 0; t < 4; ++t) { *(LAS bf16x8*)(V_lds + t * SHM_V + vst0) = vs[t][0]; *(LAS bf16x8*)(V_lds + t * SHM_V + vst1) = vs[t][1];
      if constexpr (DQK == 128) { *(LAS bf16x8*)(K_lds + t * SHM_K + FA_KSWZ(sr, sc * 2)) = ks[t][0]; *(LAS bf16x8*)(K_lds + t * SHM_K + FA_KSWZ(32 + sr, sc * 2)) = ks[t][1]; }
      else *(LAS bf16x8*)(K_lds + t * SHM_K + FA_KSWZ64(k64r, k64c * 2)) = ks[t][0]; } }
  __syncthreads();
#pragma unroll
  for (int d = 0; d < 4; ++d) o[d] = f32x16{};
  const int vb0 = (int)(uintptr_t)V_lds + v_rd_base(lane);
#define FA_RESC(a) do { if (__any((a) < 1.f)) { if (hi == 0) al_l[r32] = (a); asm volatile("s_waitcnt lgkmcnt(0)" ::: "memory"); \
    _Pragma("unroll") for (int d = 0; d < 4; ++d) _Pragma("unroll") for (int r = 0; r < 16; ++r) o[d][r] *= al_l[crow(r, hi)]; } } while (0)
  f32x16 pA0, pA1, pB0, pB1; float mnA, mnB, alA, alB; bf16x8 pa0, pa1, pa2, pa3;
  qkt<DQK>(pA0, pA1, K_lds, qr, r32, hi); partialSM<DQK>(pA0, pA1, m_reg, mnA, alA);
  FA_SBAR(); qkt<DQK>(pB0, pB1, K_lds + SHM_K, qr, r32, hi); finishSM(pA0, pA1, alA, l_reg, pa0, pa1, pa2, pa3); FA_SBAR();
  pv_d0(o, vb0, pa0, pa1, pa2, pa3); partialSM<DQK>(pB0, pB1, m_reg, mnB, alB); FA_RESC(alB);
  FA_SBAR(); qkt<DQK>(pA0, pA1, K_lds + 2 * SHM_K, qr, r32, hi); finishSM(pB0, pB1, alB, l_reg, pa0, pa1, pa2, pa3); FA_SBAR();
  pv_d0(o, vb0 + SHM_V, pa0, pa1, pa2, pa3); partialSM<DQK>(pA0, pA1, m_reg, mnA, alA); FA_RESC(alA);
  FA_SBAR(); qkt<DQK>(pB0, pB1, K_lds + 3 * SHM_K, qr, r32, hi); finishSM(pA0, pA1, alA, l_reg, pa0, pa1, pa2, pa3); FA_SBAR();
  pv_d0(o, vb0 + 2 * SHM_V, pa0, pa1, pa2, pa3); partialSM<DQK>(pB0, pB1, m_reg, mnB, alB); FA_RESC(alB);
  finishSM(pB0, pB1, alB, l_reg, pa0, pa1, pa2, pa3); FA_SBAR();
  pv_d0(o, vb0 + 3 * SHM_V, pa0, pa1, pa2, pa3);
  m_out = m_reg; l_out = l_reg;
#undef FA_RESC
}
__device__ __forceinline__ void row_bcast(float lv, lptr scratch, int wid, int r32, int hi, float (&f)[16]) {
  LAS float* li_l = (LAS float*)scratch + wid * 64;
  if (hi == 0) li_l[r32] = lv; asm volatile("s_waitcnt lgkmcnt(0)" ::: "memory");
#pragma unroll
  for (int r = 0; r < 16; ++r) f[r] = li_l[crow(r, hi)];
  asm volatile("s_waitcnt lgkmcnt(0)" ::: "memory");
}
constexpr int TILE_STRIDE = 272, TILE_BYTES = 32 * TILE_STRIDE;
__device__ __forceinline__ void tile_put(lptr tile, int r32, int hi, const f32x16 (&o)[4], const float (&sc)[16]) {
#pragma unroll
  for (int rr = 0; rr < 16; ++rr) { const int row = crow(rr, hi);
#pragma unroll
    for (int d0 = 0; d0 < 4; d0 += 2) { const unsigned w = pk2(o[d0][rr] * sc[rr], o[d0 + 1][rr] * sc[rr]);
      *(LAS bf16*)(tile + row * TILE_STRIDE + (d0 * 32 + r32) * 2) = (bf16)(w & 0xffffu); *(LAS bf16*)(tile + row * TILE_STRIDE + ((d0 + 1) * 32 + r32) * 2) = (bf16)(w >> 16); } }
}
__device__ __forceinline__ void tile_gates(int lane, const bf16* gate_rows, v4u (&gq)[8]) {
#pragma unroll
  for (int it = 0; it < 8; ++it) { const int c = it * 64 + lane, row = c >> 4, cc = (c & 15) * 8; gq[it] = *(const v4u*)(gate_rows + (size_t)row * DIN + cc); }
}
__device__ __forceinline__ void tile_emit(lptr tile, int lane, const v4u (&gq)[8], bf16* mix_rows, const float* colscale) {
#pragma unroll
  for (int it = 0; it < 8; ++it) { const int c = it * 64 + lane, row = c >> 4, cc = (c & 15) * 8;
    const v4u tv = *(const LAS v4u*)(tile + row * TILE_STRIDE + cc * 2); const v4u gv = gq[it];
    float x[8] = {blo(tv.x), bhi(tv.x), blo(tv.y), bhi(tv.y), blo(tv.z), bhi(tv.z), blo(tv.w), bhi(tv.w)};
    const float g[8] = {blo(gv.x), bhi(gv.x), blo(gv.y), bhi(gv.y), blo(gv.z), bhi(gv.z), blo(gv.w), bhi(gv.w)};
    if (colscale) { const f32x4 s0 = *(const f32x4*)(colscale + cc), s1 = *(const f32x4*)(colscale + cc + 4); x[0] *= s0.x; x[1] *= s0.y; x[2] *= s0.z; x[3] *= s0.w; x[4] *= s1.x; x[5] *= s1.y; x[6] *= s1.z; x[7] *= s1.w; }
#pragma unroll
    for (int t = 0; t < 8; ++t) x[t] *= siluf(g[t]);
    v4u w; w.x = pk2(x[0], x[1]); w.y = pk2(x[2], x[3]); w.z = pk2(x[4], x[5]); w.w = pk2(x[6], x[7]);
    *(v4u*)(mix_rows + (size_t)row * DM + cc) = w; }
}
}

template <int BR, bool LAT>
__device__ __forceinline__ void attn_fast_unit(CArgs& a, int l, int r, LAS unsigned char* lds_u, int wv) {
  fa::lptr lds = (fa::lptr)lds_u;
  const int b = LAT ? r >> 7 : r >> 3, h = LAT ? (r >> 4) & 7 : r & 7, qb = LAT ? r & 15 : 0, kv = h >> 2;
  const int rowbase = LAT ? MC + b * LSEQ : b * SEQ, q0 = qb * 256;
  const bf16* proj = (const bf16*)(a.ws + WS_PROJ); const bf16* pk = proj + (size_t)rowbase * DIN; const bf16* pq = pk + (size_t)q0 * DIN;
  fa::f32x16 o[4]; float mreg, lreg; float f[16];
  constexpr int NTL = LAT ? LSEQ / 64 : SEQ / 64, NTC = LAT ? 4 : 0;
#define FA_IDS() int tid_ = tid_of(wv); asm volatile("" : "+v"(tid_)); const int wid = tid_ >> 6, lane = tid_ & 63, r32 = lane & 31, hi = lane >> 5; (void)lane; \
  bf16* mix = (bf16*)(a.ws + WS_HM) + (size_t)(rowbase + q0 + wid * 32) * DM; const bf16* gate = pq + (size_t)(wid * 32) * DIN; (void)mix; (void)gate
  if constexpr (BR == 1) {
    const fa::Src S1{pk + B_K + kv * 128, pk + B_V + kv * 128, DIN};
    const fa::Src S2{(const bf16*)(a.ws + WS_CBK) + (size_t)(b * 2 + l) * 65536 + kv * 128, (const bf16*)(a.ws + WS_CBV) + (size_t)(b * 2 + l) * 65536 + kv * 128, 256};
    if constexpr (LAT) fa::core3<128, false>(pq + B_Q + h * 128, DIN, S1, NTL, S2, NTL + NTC, 0, 0, lds, o, mreg, lreg, wv); else fa::core_ctx<128>(pq + B_Q + h * 128, DIN, S1, lds, o, mreg, lreg, wv);
    FA_IDS();
    v4u gq[8]; fa::tile_gates(lane, gate + B_G + h * 128, gq);
    __syncthreads();
    fa::row_bcast(lreg, lds + fa::CTX_SCR, wid, r32, hi, f);
#pragma unroll
    for (int rr = 0; rr < 16; ++rr) f[rr] = __builtin_amdgcn_rcpf(f[rr]);
    fa::tile_put(lds + wid * fa::TILE_BYTES, r32, hi, o, f); __builtin_amdgcn_wave_barrier();
    fa::tile_emit(lds + wid * fa::TILE_BYTES, lane, gq, mix + 1024 + h * 128, nullptr);
  } else if constexpr (BR == 2) {
    const fa::Src SL{pk + D_K + kv * 128, pk + D_V + kv * 128, DIN};
    const fa::Src SC{(const bf16*)(a.ws + WS_CDK) + (size_t)(b * 2 + l) * 65536 + kv * 128, (const bf16*)(a.ws + WS_CDV) + (size_t)(b * 2 + l) * 65536 + kv * 128, 256};
    if constexpr (LAT) {
      const int kb = q0 - 128 < 0 ? 0 : q0 - 128, ke = q0 + 384 > LSEQ ? LSEQ : q0 + 384;
      const fa::Src SLb{SL.K + (size_t)kb * DIN, SL.V + (size_t)kb * DIN, DIN};
      fa::core3<128, true>(pq + D_Q + h * 128, DIN, SC, 4, SLb, 4 + (ke - kb) / 64, q0, kb, lds, o, mreg, lreg, wv);
    } else fa::core_ctx<128>(pq + D_Q + h * 128, DIN, SL, lds, o, mreg, lreg, wv);
    { const float sink = a.in[I_SINK][l * 8 + h]; lreg += __builtin_amdgcn_exp2f(sink * 1.4426950408889634f - mreg * (0.088388347648318440f * 1.4426950408889634f)); }
    FA_IDS();
    v4u gq[8]; fa::tile_gates(lane, gate + D_G + h * 128, gq);
    __syncthreads();
    fa::row_bcast(lreg, lds + fa::CTX_SCR, wid, r32, hi, f);
#pragma unroll
    for (int rr = 0; rr < 16; ++rr) f[rr] = __builtin_amdgcn_rcpf(f[rr]);
    fa::tile_put(lds + wid * fa::TILE_BYTES, r32, hi, o, f); __builtin_amdgcn_wave_barrier();
    fa::tile_emit(lds + wid * fa::TILE_BYTES, lane, gq, mix + 3072 + h * 128, nullptr);
  } else {
    const bf16* ck = (const bf16*)(a.ws + WS_CAK) + (size_t)(b * 2 + l) * 262144 + h * 128; const bf16* cv = (const bf16*)(a.ws + WS_CAV) + (size_t)(b * 2 + l) * 262144 + h * 128;
    { const fa::Src S1{pk + A_K + h * 128, pk + A_V + h * 128, DIN}; const fa::Src S2{ck, cv, 1024};
      if constexpr (LAT) fa::core3<64, false>(pq + A_Q + h * 128, DIN, S1, NTL, S2, NTL + NTC, 0, 0, lds, o, mreg, lreg, wv); else { fa::core_ctx<64>(pq + A_Q + h * 128, DIN, S1, lds, o, mreg, lreg, wv); } }
    { FA_IDS();
      fa::row_bcast(lreg, lds + fa::CTX_SCR, wid, r32, hi, f);
      float* scr = (float*)(a.ws + WS_ASCR) + ((size_t)blockIdx.x * 8 + wid) * 4096 + lane;
#pragma unroll
      for (int rr = 0; rr < 16; ++rr) { const float il = __builtin_amdgcn_rcpf(f[rr]);
#pragma unroll
        for (int d0 = 0; d0 < 4; ++d0) scr[(d0 * 16 + rr) * 64] = o[d0][rr] * il; } }
    { const fa::Src S1{pk + A_K + h * 128 + 64, pk + A_V + h * 128, DIN}; const fa::Src S2{ck + 64, cv, 1024};
      if constexpr (LAT) { __syncthreads(); fa::core3<64, false>(pq + A_Q + h * 128 + 64, DIN, S1, NTL, S2, NTL + NTC, 0, 0, lds, o, mreg, lreg, wv); } else { __syncthreads(); fa::core_ctx<64>(pq + A_Q + h * 128 + 64, DIN, S1, lds, o, mreg, lreg, wv); } }
    FA_IDS();
    fa::row_bcast(lreg, lds + fa::CTX_SCR, wid, r32, hi, f);
    const float* scr = (const float*)(a.ws + WS_ASCR) + ((size_t)blockIdx.x * 8 + wid) * 4096 + lane;
    const float lam = ((const float*)(a.ws + WS_LAM))[l], lam_init = l == 0 ? 0.2f : 0.35550906759f;
#pragma unroll
    for (int rr = 0; rr < 16; ++rr) { const float il = lam * __builtin_amdgcn_rcpf(f[rr]); float s = 0.f;
#pragma unroll
      for (int d0 = 0; d0 < 4; ++d0) { const float w = scr[(d0 * 16 + rr) * 64] - o[d0][rr] * il; o[d0][rr] = w; s += w * w; }
      s = red32(s);
      f[rr] = (1.f - lam_init) / sqrtf(s * (1.f / 128.f) + RMS_EPS); }
    __syncthreads();
    v4u gq[8]; fa::tile_gates(lane, gate + A_G + h * 128, gq);
    fa::tile_put(lds + wid * fa::TILE_BYTES, r32, hi, o, f); __builtin_amdgcn_wave_barrier();
    fa::tile_emit(lds + wid * fa::TILE_BYTES, lane, gq, mix + h * 128, a.in[I_SUBG] + l * 128);
  }
#undef FA_IDS
  __syncthreads();
}
namespace s5 {
using bf16x8 = __attribute__((ext_vector_type(8))) short;
using f32x16 = __attribute__((ext_vector_type(16))) float;
typedef LAS char* lptr;
constexpr int H_STRIDE = 288, SEQ_LDS = 16 * H_STRIDE, WAVE_LDS = 2 * SEQ_LDS, SEG_OFF = 8 * WAVE_LDS;
struct Par { bf16x8 bbh[4], bbl[4], cm[4]; float ar0, ai0, ar1, ai1; };
__device__ __forceinline__ void load_par(CArgs& a, int l, int d, int g, int lane, Par& P) {
    const int col = lane & 31, h = lane >> 5, c15 = lane & 15, kg = lane >> 4;
    const float* sa = (const float*)(a.ws + WS_S5A); const float* sbb = (const float*)(a.ws + WS_S5BB);
    const int base = (l * 2 + d) * 64 + g;
    { const float* pa = sa + base * 64 + 2 * col; P.ar0 = pa[0]; P.ar1 = pa[1]; P.ai0 = pa[16384]; P.ai1 = pa[16384 + 1]; }
#pragma unroll
    for (int blk = 0; blk < 4; ++blk) { const int part = blk >> 1, p = 2 * col + (blk & 1);
        const float* src = sbb + (size_t)part * 262144 + ((size_t)(base * 64 + p)) * 16 + 8 * h;
        const f32x4 x0 = *(const f32x4*)src, x1 = *(const f32x4*)(src + 4); const float x[8] = {x0.x, x0.y, x0.z, x0.w, x1.x, x1.y, x1.z, x1.w}; float lo[8];
#pragma unroll
        for (int j = 0; j < 8; ++j) lo[j] = x[j] - __uint_as_float(f2bf(x[j]) << 16);
        const v4u wh = {pk2(x[0], x[1]), pk2(x[2], x[3]), pk2(x[4], x[5]), pk2(x[6], x[7])}, wl = {pk2(lo[0], lo[1]), pk2(lo[2], lo[3]), pk2(lo[4], lo[5]), pk2(lo[6], lo[7])};
        P.bbh[blk] = __builtin_bit_cast(bf16x8, wh); P.bbl[blk] = __builtin_bit_cast(bf16x8, wl); }
#pragma unroll
    for (int ks = 0; ks < 4; ++ks) { const int part = ks >> 1, p0 = 32 * (ks & 1) + 8 * kg;
        const float* src = (part ? a.in[I_CCIM] : a.in[I_CCRE]) + ((size_t)(base * 16 + c15)) * 64 + p0;
        const f32x4 x0 = *(const f32x4*)src, x1 = *(const f32x4*)(src + 4); const float sg = part ? -1.f : 1.f;
        const v4u w = {pk2(sg * x0.x, sg * x0.y), pk2(sg * x0.z, sg * x0.w), pk2(sg * x1.x, sg * x1.y), pk2(sg * x1.z, sg * x1.w)}; P.cm[ks] = __builtin_bit_cast(bf16x8, w); }
}
template <bool FULL, int DIR>
__device__ __forceinline__ void run(const bf16* u0, const bf16* u1, int t_lo, int t_hi, const Par& P, float& hr0, float& hi0, float& hr1, float& hi1, lptr ldsw, float* yf, bf16* yact, size_t ystep, float dc, int lane) {
    const int col = lane & 31, sq = lane >> 5, c15 = lane & 15, kg = lane >> 4;
    lptr Hs = ldsw + sq * SEQ_LDS;
    const int nch = (t_hi - t_lo) >> 4;
    const bf16* up = (((col >> 2) & 1) ? u1 : u0) + (size_t)((col & 3) + 4 * (col >> 3)) * DIN + 8 * sq;
#define S5_BPROJ(U) do { _Pragma("unroll") for (int blk_ = 0; blk_ < 4; ++blk_) { acc[blk_] = __builtin_amdgcn_mfma_f32_32x32x16_bf16(U, P.bbh[blk_], f32x16{}, 0, 0, 0); acc[blk_] = __builtin_amdgcn_mfma_f32_32x32x16_bf16(U, P.bbl[blk_], acc[blk_], 0, 0, 0); } } while (0)
#define S5_T0(ci_) (DIR == 0 ? t_lo + 16 * (ci_) : t_hi - 16 - 16 * (ci_))
#define S5_ULOAD(ci_) (*(const bf16x8*)(up + (size_t)S5_T0(ci_) * DIN))
    f32x16 acc[4]; bf16x8 unext;
    { const bf16x8 u_first = S5_ULOAD(0); unext = nch > 1 ? S5_ULOAD(1) : u_first; S5_BPROJ(u_first); }
    float yn[2][4]; bf16 un[2][4];
#define S5_PREF(T0) do { _Pragma("unroll") for (int s2_ = 0; s2_ < 2; ++s2_) _Pragma("unroll") for (int i_ = 0; i_ < 4; ++i_) { const int tok_ = (T0) + 4 * kg + i_; \
        yn[s2_][i_] = yf[((size_t)tok_ + ystep * s2_) * 1024 + c15]; un[s2_][i_] = (s2_ ? u1 : u0)[(size_t)tok_ * DIN + c15]; } } while (0)
    if constexpr (FULL && DIR == 1) S5_PREF(S5_T0(0));
    for (int ci = 0; ci < nch; ++ci) {
        const int t0 = S5_T0(ci);
        float yc[2][4]; bf16 uc[2][4];
        if constexpr (FULL && DIR == 1) {
#pragma unroll
            for (int s2 = 0; s2 < 2; ++s2)
#pragma unroll
                for (int i = 0; i < 4; ++i) { yc[s2][i] = yn[s2][i]; uc[s2][i] = un[s2][i]; }
            if (ci + 1 < nch) S5_PREF(S5_T0(ci + 1));
        }
#pragma unroll
        for (int s = 0; s < 16; ++s) { const int r = DIR == 0 ? s : 15 - s;
            const float n0r = P.ar0 * hr0 - P.ai0 * hi0 + acc[0][r], n0i = P.ar0 * hi0 + P.ai0 * hr0 + acc[2][r]; hr0 = n0r; hi0 = n0i;
            const float n1r = P.ar1 * hr1 - P.ai1 * hi1 + acc[1][r], n1i = P.ar1 * hi1 + P.ai1 * hr1 + acc[3][r]; hr1 = n1r; hi1 = n1i;
            if constexpr (FULL) { *(LAS unsigned*)(Hs + r * H_STRIDE + col * 4) = pk2(hr0, hr1); *(LAS unsigned*)(Hs + r * H_STRIDE + 128 + col * 4) = pk2(hi0, hi1); } }
        if (ci + 1 < nch) { const bf16x8 ucur = unext; if (ci + 2 < nch) unext = S5_ULOAD(ci + 2); S5_BPROJ(ucur); }
        if constexpr (FULL) {
            __builtin_amdgcn_wave_barrier();
#pragma unroll
            for (int s2 = 0; s2 < 2; ++s2) {
                f32x4 y = {0.f, 0.f, 0.f, 0.f};
#pragma unroll
                for (int ks = 0; ks < 4; ++ks) { const bf16x8 af = *(const LAS bf16x8*)(ldsw + s2 * SEQ_LDS + c15 * H_STRIDE + (32 * ks + 8 * kg) * 2); y = __builtin_amdgcn_mfma_f32_16x16x32_bf16(af, P.cm[ks], y, 0, 0, 0); }
#pragma unroll
                for (int i = 0; i < 4; ++i) { const int tok = t0 + 4 * kg + i; const size_t yo = ((size_t)tok + ystep * s2) * 1024 + c15;
                    if constexpr (DIR == 0) yf[yo] = y[i];
                    else { const float v = yc[s2][i] + y[i] + bf2f(uc[s2][i]) * dc; yact[yo] = (bf16)f2bf(gelu_tanh(v)); } }
            }
            __builtin_amdgcn_wave_barrier();
        }
    }
#undef S5_PREF
#undef S5_BPROJ
#undef S5_T0
#undef S5_ULOAD
}
__device__ __forceinline__ void ctx_unit(CArgs& a, int l, int cu, lptr ldsw, int lane) {
    const int bp = cu & 15, g = cu >> 4; const int rowbase = bp * SEQ; const int col = lane & 31, sq = lane >> 5, b = bp + 16 * sq;
    const bf16* u0 = (const bf16*)(a.ws + WS_PROJ) + (size_t)rowbase * DIN + C_U + g * 16; const bf16* u1 = u0 + (size_t)16 * SEQ * DIN;
    float* yf = (float*)(a.ws + WS_YD) + (size_t)rowbase * 1024 + g * 16; bf16* yact = (bf16*)(a.ws + WS_YACT) + (size_t)rowbase * 1024 + g * 16;
    const float dc = a.in[I_CD][l * 1024 + g * 16 + (lane & 15)];
    Par P;
    { load_par(a, l, 0, g, lane, P); float h0r = 0.f, h0i = 0.f, h1r = 0.f, h1i = 0.f; run<true, 0>(u0, u1, 0, SEQ, P, h0r, h0i, h1r, h1i, ldsw, yf, yact, (size_t)16 * SEQ, dc, lane);
      const int oi = (((b * 2 + l) * 2 + 0) * 64 + g) * 64 + 2 * col; *(v2u*)(a.out + O_CRE + oi) = (v2u){__float_as_uint(h0r), __float_as_uint(h1r)}; *(v2u*)(a.out + O_CIM + oi) = (v2u){__float_as_uint(h0i), __float_as_uint(h1i)}; }
    { load_par(a, l, 1, g, lane, P); float h0r = 0.f, h0i = 0.f, h1r = 0.f, h1i = 0.f; run<true, 1>(u0, u1, 0, SEQ, P, h0r, h0i, h1r, h1i, ldsw, yf, yact, (size_t)16 * SEQ, dc, lane);
      const int oi = (((b * 2 + l) * 2 + 1) * 64 + g) * 64 + 2 * col; *(v2u*)(a.out + O_CRE + oi) = (v2u){__float_as_uint(h0r), __float_as_uint(h1r)}; *(v2u*)(a.out + O_CIM + oi) = (v2u){__float_as_uint(h0i), __float_as_uint(h1i)}; }
}
template <int NSQ> __device__ __forceinline__ void cpow2n(float ar, float ai, float& pr, float& pi) { pr = ar; pi = ai;
#pragma unroll
    for (int i = 0; i < NSQ; ++i) { const float nr = pr * pr - pi * pi, ni = 2.f * pr * pi; pr = nr; pi = ni; } }
__device__ __forceinline__ void lat_pass1(CArgs& a, int l, int lu, lptr lds, int wave, int lane) {
    const int g = lu >> 2, seg = (lu & 3) * 8 + wave;
    const bf16* u0 = (const bf16*)(a.ws + WS_PROJ) + (size_t)MC * DIN + C_U + g * 16; const bf16* u1 = u0 + (size_t)LSEQ * DIN;
    f32x4* SEG = (f32x4*)(a.ws + WS_SEG);
    const int t_lo = seg * 128, t_hi = t_lo + 128;
    Par P;
#pragma unroll
    for (int d = 0; d < 2; ++d) { load_par(a, l, d, g, lane, P); float h0r = 0.f, h0i = 0.f, h1r = 0.f, h1i = 0.f;
        if (d == 0) run<false, 0>(u0, u1, t_lo, t_hi, P, h0r, h0i, h1r, h1i, lds, nullptr, nullptr, 0, 0.f, lane); else run<false, 1>(u0, u1, t_lo, t_hi, P, h0r, h0i, h1r, h1i, lds, nullptr, nullptr, 0, 0.f, lane);
        SEG[((size_t)(g * 2 + d) * 32 + seg) * 64 + lane] = (f32x4){h0r, h0i, h1r, h1i}; }
}
__device__ __forceinline__ void lat_pass2(CArgs& a, int l, int lu, lptr lds, int wave, int lane) {
    const int g = lu >> 2, seg = (lu & 3) * 8 + wave; const int col = lane & 31, sq = lane >> 5;
    const bf16* u0 = (const bf16*)(a.ws + WS_PROJ) + (size_t)MC * DIN + C_U + g * 16; const bf16* u1 = u0 + (size_t)LSEQ * DIN;
    float* yf = (float*)(a.ws + WS_YD) + (size_t)MC * 1024 + g * 16; bf16* yact = (bf16*)(a.ws + WS_YACT) + (size_t)MC * 1024 + g * 16;
    const float dc = a.in[I_CD][l * 1024 + g * 16 + (lane & 15)];
    const f32x4* SEG = (const f32x4*)(a.ws + WS_SEG);
    lptr ldsw = lds + wave * WAVE_LDS;
    const int t_lo = seg * 128, t_hi = t_lo + 128;
    Par P;
#pragma unroll
    for (int d = 0; d < 2; ++d) { load_par(a, l, d, g, lane, P); float p0r, p0i, p1r, p1i; cpow2n<7>(P.ar0, P.ai0, p0r, p0i); cpow2n<7>(P.ar1, P.ai1, p1r, p1i);
        const int si = (((sq * 2 + l) * 2 + d) * 64 + g) * 64 + 2 * col;
        float h0r = a.in[I_SRE][si], h0i = a.in[I_SIM][si], h1r = a.in[I_SRE][si + 1], h1i = a.in[I_SIM][si + 1];
        const int nv = d == 0 ? seg : 31 - seg;
        const f32x4* sp = SEG + ((size_t)(g * 2 + d) * 32) * 64 + lane;
        for (int k0 = 0; k0 < nv; k0 += 8) {
            f32x4 sv[8];
#pragma unroll
            for (int j = 0; j < 8; ++j) { const int k = k0 + j < nv ? k0 + j : nv - 1; const int v = d == 0 ? k : 31 - k; sv[j] = sp[(size_t)v * 64]; }
#pragma unroll
            for (int j = 0; j < 8; ++j) if (k0 + j < nv) { const f32x4 s = sv[j];
                const float n0r = p0r * h0r - p0i * h0i + s.x, n0i = p0r * h0i + p0i * h0r + s.y, n1r = p1r * h1r - p1i * h1i + s.z, n1i = p1r * h1i + p1i * h1r + s.w; h0r = n0r; h0i = n0i; h1r = n1r; h1i = n1i; }
        }
        if (d == 0) run<true, 0>(u0, u1, t_lo, t_hi, P, h0r, h0i, h1r, h1i, ldsw, yf, yact, (size_t)LSEQ, dc, lane); else run<true, 1>(u0, u1, t_lo, t_hi, P, h0r, h0i, h1r, h1i, ldsw, yf, yact, (size_t)LSEQ, dc, lane); }
}
}
__global__ void __launch_bounds__(NTHREADS, 2) fwd(Args args_by_value) {
    extern __shared__ __attribute__((aligned(16))) unsigned char lds_raw[];
    LAS unsigned char* lds = (LAS unsigned char*)lds_raw;
    volatile LAS unsigned* MISC = (volatile LAS unsigned*)(lds + MISC_OFF);
#define IDS() int tid_ = tid_of(wv); asm volatile("" : "+v"(tid_)); const int lane = tid_ & 63, wave = __builtin_amdgcn_readfirstlane(tid_ >> 6); const int G = gridDim.x, gw = blockIdx.x * NWAVES + wave, NGW = G * NWAVES; (void)lane; (void)gw; (void)NGW; (void)G; \
    CArgs* kp_ = (CArgs*)__builtin_amdgcn_kernarg_segment_ptr(); asm volatile("" : "+s"(kp_)); CArgs& args = *kp_; \
    unsigned char* ws = args.ws; const float* ada_l = (const float*)(ws + WS_ADA) + (size_t)l * 3 * 12288; bf16* HM = (bf16*)(ws + WS_HM); bf16* PROJ = (bf16*)(ws + WS_PROJ); bf16* XR = (bf16*)(ws + WS_XR); (void)ada_l; (void)HM; (void)PROJ; (void)XR
    const int wv = __builtin_amdgcn_readfirstlane((int)threadIdx.x >> 6);
    for (int u = threadIdx.x; u < (LDS_BYTES - LDSCTL_OFF) / 4; u += NTHREADS) ((LAS unsigned*)(lds + LDSCTL_OFF))[u] = 0u;
    __syncthreads();
    XcdBarrier bar;
#define GRID_BAR() do { XcdBarrier b_ = bar; asm volatile("" : "+s"(b_.x)); xcd_barrier(b_, tid_of(wv) == 0); } while (0)
    { CArgs& args0 = *(CArgs*)__builtin_amdgcn_kernarg_segment_ptr(); bar = xcd_barrier_post((unsigned*)(args0.ws + WS_CTL) + CW_BAR, MISC + 8, tid_of(wv) == 0);
      p0_ada(args0, lds, wv); }
    GRID_BAR();
    { const int l = 0; IDS(); p0_prologue(args, lds, wv);
      { LAS unsigned char* buf = lds + wave * 16384; int m = gw; if (m < M) row_dma<16>(x_row_in(args, m), buf, lane);
        for (; m < M; m += NGW) { f32x4 v[16];
          asm volatile("s_waitcnt vmcnt(0)" ::: "memory"); row_lds_f32(buf, lane, v); asm volatile("s_waitcnt lgkmcnt(0)" ::: "memory");
          if (m + NGW < M) row_dma<16>(x_row_in(args, m + NGW), buf, lane);
          ln_mod_apply(v, ada_l + (size_t)cond_of_row(m) * 12288, HM + (size_t)m * DM, lane); } } }
    GRID_BAR();

    for (int l = 0; l < DEPTH; ++l) {
        { IDS();
            pg8::Gemm g{HM, (const bf16*)(ws + WS_WIN) + (size_t)l * DIN * DM, M, DIN, DM}; pg8::StaticOrder S; S.init(M, DIN, G, (int)blockIdx.x);
            pg8::EpiBf16<0> E{PROJ, DIN, nullptr, 0, 0, 1.f};
            pg8::gemm_phase<pg8::EpiBf16<0>, pg8::StaticOrder, true, true>(lds + RING_OFF, g, S, E, wv); }
        GRID_BAR();
        { IDS();
            for (int lu = blockIdx.x; lu < 256; lu += G) s5::lat_pass1(args, l, lu, (s5::lptr)lds + wave * s5::WAVE_LDS, wave, lane);
            if (wave < 4) { for (int cu = (int)blockIdx.x * 4 + wave; cu < 1024; cu += G * 4) s5::ctx_unit(args, l, cu, (s5::lptr)lds + wave * s5::WAVE_LDS, lane); }
            else for (int m = (int)blockIdx.x * 4 + wave - 4; m < M; m += G * 4) post_row(args, l, m, lane);
            GRID_BAR();
            for (int lu = blockIdx.x; lu < 256; lu += G) s5::lat_pass2(args, l, lu, (s5::lptr)lds, wave, lane); }
        GRID_BAR();
        { IDS();
            const int xg = (int)blockIdx.x & 7, ig = (int)blockIdx.x >> 3;
            const int u_bd = G == 256 ? ((((xg >> 1) * 4 + ((xg & 1) * 2 + (ig >> 4))) * 16) + (ig & 15)) : -1;
            const int u_a = G == 256 ? (((xg * 2 + (ig >> 4)) * 16) + (ig & 15)) : -1;
            for (int u = blockIdx.x; u < 256; u += G) attn_fast_unit<1, true>(args, l, G == 256 ? u_bd : u, lds, wv);
            for (int u = blockIdx.x; u < 256; u += G) attn_fast_unit<2, true>(args, l, G == 256 ? u_bd : u, lds, wv);
            for (int u = blockIdx.x; u < 256; u += G) attn_fast_unit<1, false>(args, l, u, lds, wv);
            for (int u = blockIdx.x; u < 256; u += G) attn_fast_unit<2, false>(args, l, u, lds, wv);
            for (int u = blockIdx.x; u < 256; u += G) attn_fast_unit<0, true>(args, l, G == 256 ? u_a : u, lds, wv);
            for (int u = blockIdx.x; u < 256; u += G) attn_fast_unit<0, false>(args, l, u, lds, wv);
            pg8::Gemm g{(const bf16*)(ws + WS_YACT), (const bf16*)(ws + WS_GLU) + (size_t)l * 1024 * 1024, M, 1024, 1024}; pg8::StaticOrder S; S.init(M, 1024, G, (int)blockIdx.x);
            pg8::EpiGlu E{HM, (const bf16*)(ws + WS_YACT), PROJ, args.in[I_GLUB] + l * 1024, DM, 1024, DIN, 2048, C_G};
            pg8::gemm_phase<pg8::EpiGlu, pg8::StaticOrder, true, true>(lds + RING_OFF, g, S, E, wv); }
        GRID_BAR();
        { IDS();
            pg8::Gemm g{HM, (const bf16*)(ws + WS_WOUT) + (size_t)l * DM * DM, M, DM, DM}; pg8::StaticOrder S; S.init(M, DM, G, (int)blockIdx.x);
            pg8::EpiOut E{XR, args.in[I_XP], args.in[I_XS], l == 0 ? (const bf16*)nullptr : XR, ada_l + 8192, DN_ALPHA};
            pg8::gemm_phase<pg8::EpiOut, pg8::StaticOrder, true, true>(lds + RING_OFF, g, S, E, wv); }
        GRID_BAR();
        { IDS();
            const float* g = args.in[I_LNG] + l * DM; const float* b = args.in[I_LNB] + l * DM;
            if (l == 0) { const float* ada_n = (const float*)(ws + WS_ADA) + (size_t)3 * 12288;
                LAS unsigned char* buf = lds + wave * 16384; int m = gw; if (m < M) row_dma<8>(XR + (size_t)m * DM, buf, lane);
                for (; m < M; m += NGW) { v2u r[16];
                  asm volatile("s_waitcnt vmcnt(0)" ::: "memory"); row_lds_bf16(buf, lane, r); asm volatile("s_waitcnt lgkmcnt(0)" ::: "memory");
                  if (m + NGW < M) row_dma<8>(XR + (size_t)(m + NGW) * DM, buf, lane);
                  ln_final_mod_apply(r, g, b, XR + (size_t)m * DM, ada_n + (size_t)cond_of_row(m) * 12288, HM + (size_t)m * DM, lane); } }
            else { LAS unsigned char* buf = lds + wave * 16384; int m = gw; if (m < M) row_dma<8>(XR + (size_t)m * DM, buf, lane);
                for (; m < M; m += NGW) { v2u r[16];
                  asm volatile("s_waitcnt vmcnt(0)" ::: "memory"); row_lds_bf16(buf, lane, r); asm volatile("s_waitcnt lgkmcnt(0)" ::: "memory");
                  if (m + NGW < M) row_dma<8>(XR + (size_t)(m + NGW) * DM, buf, lane);
                  ln_final_apply(r, g, b, args.out + (size_t)m * DM, lane); } } }
        if (l + 1 < DEPTH) GRID_BAR();
    }
#undef IDS
#undef GRID_BAR
}

extern "C" void kernel_launch(void* const* d_in, const int* in_sizes, int n_in, void* d_out, int out_size, void* d_ws, size_t ws_size, hipStream_t stream) {
    static int grid = 0;
    if (grid == 0) {
        if (n_in != N_IN || (size_t)out_size != O_END || ws_size < WS_END) { fprintf(stderr, "kernel_launch: unexpected shapes: n_in %d out %d ws %zu (need %zu)\n", n_in, out_size, ws_size, (size_t)WS_END); grid = -1; return; }
        int dev = 0, cus = 0;
        if (hipGetDevice(&dev) != hipSuccess || hipDeviceGetAttribute(&cus, hipDeviceAttributeMultiprocessorCount, dev) != hipSuccess) { grid = -1; return; }
        if (hipFuncSetAttribute((const void*)fwd, hipFuncAttributeMaxDynamicSharedMemorySize, LDS_BYTES) != hipSuccess) { fprintf(stderr, "kernel_launch: hipFuncSetAttribute failed\n"); grid = -1; return; }
        int per_cu = 0;
        if (hipOccupancyMaxActiveBlocksPerMultiprocessor(&per_cu, (const void*)fwd, NTHREADS, LDS_BYTES) != hipSuccess || per_cu < 1) fprintf(stderr, "kernel_launch: note: occupancy query reports %d\n", per_cu);
        (void)hipGetLastError();
        grid = cus;
    }
    if (grid < 0) return;
    (void)hipMemsetAsync((char*)d_ws + WS_CTL, 0, CTL_ZERO_BYTES, stream);
    Args a{};
    for (int i = 0; i < N_IN; ++i) a.in[i] = (const float*)d_in[i];
    a.out = (float*)d_out; a.ws = (unsigned char*)d_ws;
    hipLaunchKernelGGL(fwd, dim3(grid), dim3(NTHREADS), LDS_BYTES, stream, a);
    const hipError_t le = hipPeekAtLastError();
    if (le != hipSuccess) fprintf(stderr, "kernel_launch: launch failed: %s\n", hipGetErrorName(le));
}
```

```cpp
#include <hip/hip_runtime.h>
#include <cstdio>
#include <cstdint>
__device__ __forceinline__ int lane_id() { int l; asm volatile("v_mbcnt_lo_u32_b32 %0, -1, 0\n\tv_mbcnt_hi_u32_b32 %0, -1, %0" : "=v"(l)); return l; }
__device__ __forceinline__ int tid_of(int wv) { return (wv << 6) | lane_id(); }
namespace pg8 {
#define PG8_LAS __attribute__((address_space(3)))
typedef unsigned short bf16_t;
typedef short bf16x8 __attribute__((ext_vector_type(8)));
typedef float f32x4 __attribute__((ext_vector_type(4)));
typedef unsigned u32x4 __attribute__((ext_vector_type(4)));
constexpr int BM = 256, BK = 64, HALF = 128, HTB = HALF * BK * 2  , STAGE_BYTES = 8 * HTB, NXCD = 8, WGM = 8;

__host__ __device__ __forceinline__ int lds_byte(int r, int c) { const int st = (r >> 4) * 2 + (c >> 5), rr = r & 15, cc = c & 31, ob = rr * 64 + cc * 2; return st * 1024 + (ob ^ (((ob >> 9) & 1) << 5)); }
__host__ __device__ __forceinline__ void stage_rc(int b, int& R, int& C) { const int st = b / 1024, sb = b % 1024, swz = sb ^ (((sb >> 9) & 1) << 5); R = (st >> 1) * 16 + swz / 64; C = (st & 1) * 32 + (swz % 64) / 2; }
__host__ __device__ __forceinline__ int perm32(int rho) { const int n = rho >> 4, i = rho & 15; return 8 * (i >> 2) + 4 * n + (i & 3); }

struct Unit { int pm, pn; };
struct Gemm { const bf16_t* A; const bf16_t* Bt; int M, N, K; };

struct StaticOrder {
    int nM, nN, nwg, G, c;
    __host__ __device__ void init(int M, int N, int G_, int c_) { nM = M / BM; nN = N / BM; nwg = nM * nN; G = G_; c = c_; }
    __host__ __device__ bool next(int i, Unit& u) const {
        const long L = (long)i * G + c; if (L >= nwg) return false;
        int wgid = (int)L; { const int q = nwg / NXCD, r = nwg % NXCD, xcd = wgid % NXCD, off = wgid / NXCD; wgid = (xcd < r ? xcd * (q + 1) : r * (q + 1) + (xcd - r) * q) + off; }
        const int nig = WGM * nN, gid = wgid / nig, fm = gid * WGM, gsz = (nM - fm) < WGM ? (nM - fm) : WGM;
        u.pm = fm + ((wgid % nig) % gsz); u.pn = (wgid % nig) / gsz; return true;
    }
    __device__ __forceinline__ void a_ready(const Unit&) const {}
    __device__ __forceinline__ void done(const Unit&) const {}
};

__device__ __forceinline__ unsigned cvt_pk_bf16(float lo, float hi) { unsigned r; asm volatile("v_cvt_pk_bf16_f32 %0, %1, %2" : "=v"(r) : "v"(lo), "v"(hi)); return r; }
typedef float f32x2 __attribute__((ext_vector_type(2)));
__device__ __forceinline__ f32x2 gelu_pk(f32x2 v) {
    const f32x2 av = __builtin_elementwise_abs(v), d = av * 0.2316418882f + 1.0f;
    f32x2 t; t.x = __builtin_amdgcn_rcpf(d.x); t.y = __builtin_amdgcn_rcpf(d.y);
    f32x2 q = t * 0.5307027145f + (-0.7265760135f); q = q * t + 0.7107068705f; q = q * t + (-0.142248368f); q = q * t + 0.127414796f; q = q * t;
    const f32x2 s = (v * v) * (-0.72134752044f);
    f32x2 e; e.x = __builtin_amdgcn_exp2f(s.x); e.y = __builtin_amdgcn_exp2f(s.y);
    const f32x2 m = v * (q * e), r = v - m;
    f32x2 o; o.x = v.x < 0.f ? m.x : r.x; o.y = v.y < 0.f ? m.y : r.y; return o;
}

template <int ACT  > struct EpiBf16 {
    static constexpr bool PERM = true, AFTER_DRAIN = false; static_assert(ACT == 0 || ACT == 1, "EpiBf16: ACT is 0 (none) or 1 (gelu_pk)");
    bf16_t* O; int ldc; const float* bias; int split_cols; size_t split_stride; float scale0;
    __device__ __forceinline__ void operator()(const f32x4 (&acc)[2][2][4][2], const Unit& u, int wr, int wc, int fr, int fq) const {
        const int row0 = u.pm * BM + wr * 64 + fr; int colt = u.pn * BM; bf16_t* base = O;
        float sc = 1.f; if (split_cols) { const int t = colt / split_cols; base += (size_t)t * split_stride; colt -= t * split_cols; if (t == 0) sc = scale0; }
        const int col0 = colt + wc * 32 + 8 * fq, bcol0 = u.pn * BM + wc * 32 + 8 * fq;
        f32x4 bv[2][2];
#pragma unroll
        for (int bj = 0; bj < 2; ++bj)
#pragma unroll
            for (int n = 0; n < 2; ++n) bv[bj][n] = bias ? *(const f32x4*)(bias + bcol0 + bj * HALF + 4 * n) : (f32x4){0.f, 0.f, 0.f, 0.f};
#pragma unroll
        for (int ai = 0; ai < 2; ++ai)
#pragma unroll
            for (int m = 0; m < 4; ++m) { bf16_t* rowp = base + (size_t)(row0 + ai * HALF + m * 16) * ldc + col0;
#pragma unroll
                for (int bj = 0; bj < 2; ++bj) { f32x4 v0 = acc[ai][bj][m][0] + bv[bj][0], v1 = acc[ai][bj][m][1] + bv[bj][1];
                    if (ACT == 1) { f32x2 a = gelu_pk((f32x2){v0[0], v0[1]}), b = gelu_pk((f32x2){v0[2], v0[3]}), c = gelu_pk((f32x2){v1[0], v1[1]}), d = gelu_pk((f32x2){v1[2], v1[3]});
                        v0 = (f32x4){a.x, a.y, b.x, b.y}; v1 = (f32x4){c.x, c.y, d.x, d.y}; }
                    v0 = v0 * sc; v1 = v1 * sc; u32x4 w; w.x = cvt_pk_bf16(v0[0], v0[1]); w.y = cvt_pk_bf16(v0[2], v0[3]); w.z = cvt_pk_bf16(v1[0], v1[1]); w.w = cvt_pk_bf16(v1[2], v1[3]);
                    *(u32x4*)(rowp + bj * HALF) = w; } }
    }
};

__device__ __forceinline__ float bf_lo(unsigned w) { return __uint_as_float(w << 16); }
__device__ __forceinline__ float bf_hi(unsigned w) { return __uint_as_float(w & 0xffff0000u); }
__device__ __forceinline__ float sigmoid_f(float x) { return __builtin_amdgcn_rcpf(1.f + __expf(-x)); }
__device__ __forceinline__ float silu_f(float x) { return x * __builtin_amdgcn_rcpf(1.f + __expf(-x)); }
struct EpiGlu {
    static constexpr bool PERM = true, AFTER_DRAIN = false;
    bf16_t* MIX; const bf16_t* Y; const bf16_t* PROJ; const float* bias; int ld_mix, ld_y, ld_proj, mix_col0, gate_col0;
    __device__ __forceinline__ void operator()(const f32x4 (&acc)[2][2][4][2], const Unit& u, int wr, int wc, int fr, int fq) const {
        const int row0 = u.pm * BM + wr * 64 + fr, col0 = u.pn * BM + wc * 32 + 8 * fq;
#pragma unroll
        for (int ai = 0; ai < 2; ++ai)
#pragma unroll
            for (int m = 0; m < 4; ++m) { const size_t row = (size_t)(row0 + ai * HALF + m * 16);
#pragma unroll
                for (int bj = 0; bj < 2; ++bj) { const int c = col0 + bj * HALF;
                    const f32x4 b0 = *(const f32x4*)(bias + c), b1 = *(const f32x4*)(bias + c + 4);
                    const u32x4 yv = *(const u32x4*)(Y + row * ld_y + c), gv = *(const u32x4*)(PROJ + row * ld_proj + gate_col0 + c);
                    const f32x4 v0 = acc[ai][bj][m][0] + b0, v1 = acc[ai][bj][m][1] + b1;
                    float o[8]; const float z[8] = {v0[0], v0[1], v0[2], v0[3], v1[0], v1[1], v1[2], v1[3]};
                    const unsigned yw[4] = {yv.x, yv.y, yv.z, yv.w}, gw[4] = {gv.x, gv.y, gv.z, gv.w};
#pragma unroll
                    for (int j = 0; j < 4; ++j) { o[2 * j] = bf_lo(yw[j]) * sigmoid_f(z[2 * j]) * silu_f(bf_lo(gw[j])); o[2 * j + 1] = bf_hi(yw[j]) * sigmoid_f(z[2 * j + 1]) * silu_f(bf_hi(gw[j])); }
                    u32x4 w; w.x = cvt_pk_bf16(o[0], o[1]); w.y = cvt_pk_bf16(o[2], o[3]); w.z = cvt_pk_bf16(o[4], o[5]); w.w = cvt_pk_bf16(o[6], o[7]);
                    *(u32x4*)(MIX + row * ld_mix + mix_col0 + c) = w; } }
    }
};
struct EpiOut {
    static constexpr bool PERM = true, AFTER_DRAIN = false;
    bf16_t* XR; const float* xc; const float* xl; const bf16_t* x16; const float* gate; float alpha;
    __device__ __forceinline__ void operator()(const f32x4 (&acc)[2][2][4][2], const Unit& u, int wr, int wc, int fr, int fq) const {
        const int row0 = u.pm * BM + wr * 64 + fr, col0 = u.pn * BM + wc * 32 + 8 * fq;
        const int v = u.pm < 32 ? 0 : 1 + ((u.pm - 32) >> 4);
        const float* xb = u.pm < 32 ? xc : xl; const int rsub = u.pm < 32 ? 0 : 8192;
#pragma unroll
        for (int bj = 0; bj < 2; ++bj) {
            const f32x4 g0 = *(const f32x4*)(gate + (size_t)v * 12288 + col0 + bj * HALF), g1 = *(const f32x4*)(gate + (size_t)v * 12288 + col0 + bj * HALF + 4);
#pragma unroll
            for (int ai = 0; ai < 2; ++ai)
#pragma unroll
                for (int m = 0; m < 4; ++m) { const size_t off = (size_t)(row0 + ai * HALF + m * 16) * 4096 + col0 + bj * HALF; f32x4 x0, x1;
                    if (x16) { const u32x4 w = *(const u32x4*)(x16 + off); x0 = (f32x4){bf_lo(w.x), bf_hi(w.x), bf_lo(w.y), bf_hi(w.y)}; x1 = (f32x4){bf_lo(w.z), bf_hi(w.z), bf_lo(w.w), bf_hi(w.w)}; }
                    else { const float* xp = xb + (off - (size_t)rsub * 4096); x0 = *(const f32x4*)xp; x1 = *(const f32x4*)(xp + 4); }
                    const f32x4 o0 = x0 * alpha + g0 * acc[ai][bj][m][0], o1 = x1 * alpha + g1 * acc[ai][bj][m][1];
                    u32x4 w; w.x = cvt_pk_bf16(o0[0], o0[1]); w.y = cvt_pk_bf16(o0[2], o0[3]); w.z = cvt_pk_bf16(o1[0], o1[1]); w.w = cvt_pk_bf16(o1[2], o1[3]);
                    *(u32x4*)(XR + off) = w;
                    if (m & 1) asm volatile("" ::: "memory"); }
        }
    }
};
template <class Epi, class Sched, bool ALIGN_EPI = false, bool SP2 = false>
__device__ __forceinline__ void gemm_phase(PG8_LAS unsigned char* lds, const Gemm g, const Sched& S, const Epi& E, int wv) {
    int tid = tid_of(wv); asm volatile("" : "+v"(tid));
    const int wid = __builtin_amdgcn_readfirstlane(tid >> 6), lane = tid & 63, wr = wid >> 2, wc = wid & 3, fr = lane & 15, fq = lane >> 4;
    const int K = g.K, nt = K / BK;
    unsigned voffA[2], voffB[2];
#pragma unroll
    for (int i = 0; i < 2; ++i) { int R, C; stage_rc(tid * 16 + i * 8192, R, C); const int Rb = Epi::PERM ? ((R & ~31) + perm32(R & 31)) : R;
        voffA[i] = (unsigned)(R * K + C) * 2u; voffB[i] = (unsigned)(Rb * K + C) * 2u; }
    const size_t kstep = (size_t)(BK * 2);
    const size_t hstep = (size_t)HALF * K * 2;
    const size_t tstep = 2 * hstep;
    const unsigned ldsw = (unsigned)wid * 1024u;
    const int aoff = lds_byte(wr * 64 + fr, fq * 8), boff = lds_byte(wc * 32 + fr, fq * 8);
#define PG8_SA(b, h) (((b) * 2 + (h)) * HTB)
#define PG8_SB(b, h) ((4 + (b) * 2 + (h)) * HTB)
#define PG8_STAGE(bufoff, gbase, voff) do { _Pragma("unroll") for (int _i = 0; _i < 2; ++_i) \
        __builtin_amdgcn_global_load_lds((const unsigned*)((const char*)(gbase) + (voff)[_i]), (PG8_LAS unsigned*)(lds + (bufoff) + ldsw + _i * 8192), 16, 0, 0); } while (0)
#define PG8_LDA(dst, b, h) do { _Pragma("unroll") for (int m = 0; m < 4; ++m) _Pragma("unroll") for (int k = 0; k < 2; ++k) dst[m][k] = *(const PG8_LAS bf16x8*)(lds + PG8_SA(b, h) + aoff + m * 2048 + k * 1024); } while (0)
#define PG8_LDB(dst, b, h) do { _Pragma("unroll") for (int n = 0; n < 2; ++n) _Pragma("unroll") for (int k = 0; k < 2; ++k) dst[n][k] = *(const PG8_LAS bf16x8*)(lds + PG8_SB(b, h) + boff + n * 2048 + k * 1024); } while (0)
#define PG8_MMA(ai, bj, At, Bt) do { __builtin_amdgcn_s_setprio(1); _Pragma("unroll") for (int m = 0; m < 4; ++m) _Pragma("unroll") for (int n = 0; n < 2; ++n) _Pragma("unroll") for (int k = 0; k < 2; ++k) \
        acc[ai][bj][m][n] = __builtin_amdgcn_mfma_f32_16x16x32_bf16(Bt[n][k], At[m][k], acc[ai][bj][m][n], 0, 0, 0); __builtin_amdgcn_s_setprio(0); } while (0)
#define PG8_WAIT_V(n) asm volatile("s_waitcnt vmcnt(" #n ")" ::: "memory")
#define PG8_WAIT_L(n) asm volatile("s_waitcnt lgkmcnt(" #n ")" ::: "memory")
#define PG8_BAR __builtin_amdgcn_s_barrier()
#define PG8_SCHED __builtin_amdgcn_sched_barrier(0)
    Unit cur, nxt; int ui = 0;
    if (!S.next(0, cur)) return;
    f32x4 acc[2][2][4][2];
#pragma unroll
    for (int a = 0; a < 2; ++a)
#pragma unroll
        for (int b = 0; b < 2; ++b)
#pragma unroll
            for (int m = 0; m < 4; ++m)
#pragma unroll
                for (int n = 0; n < 2; ++n) acc[a][b][m][n] = (f32x4){0.f, 0.f, 0.f, 0.f};
    bf16x8 At[4][2], B0[2][2], B1[2][2];
    const char* cA = (const char*)g.A + (size_t)cur.pm * tstep; const char* cB = (const char*)g.Bt + (size_t)cur.pn * tstep;
    S.a_ready(cur);
    if constexpr (SP2) {
        PG8_STAGE(PG8_SB(0, 0), cB, voffB); PG8_STAGE(PG8_SB(0, 1), cB + hstep, voffB); PG8_STAGE(PG8_SA(0, 0), cA, voffA); PG8_STAGE(PG8_SA(0, 1), cA + hstep, voffA);
        if (wr == 1) PG8_BAR;
        PG8_WAIT_V(2); PG8_BAR;
        PG8_STAGE(PG8_SB(1, 0), cB + kstep, voffB); PG8_STAGE(PG8_SA(1, 0), cA + kstep, voffA); PG8_STAGE(PG8_SB(1, 1), cB + hstep + kstep, voffB);
        PG8_WAIT_V(6); PG8_BAR;
    } else {
        PG8_STAGE(PG8_SB(0, 0), cB, voffB); PG8_STAGE(PG8_SA(0, 0), cA, voffA); PG8_STAGE(PG8_SB(0, 1), cB + hstep, voffB); PG8_STAGE(PG8_SA(0, 1), cA + hstep, voffA);
        if (wr == 1) PG8_BAR;
        PG8_WAIT_V(4); PG8_BAR;
        PG8_STAGE(PG8_SB(1, 0), cB + kstep, voffB); PG8_STAGE(PG8_SA(1, 0), cA + kstep, voffA); PG8_STAGE(PG8_SB(1, 1), cB + hstep + kstep, voffB);
        PG8_WAIT_V(6); PG8_BAR;
    }
    for (;;) {
        const bool has_next = S.next(ui + 1, nxt);
        const char* nA = has_next ? (const char*)g.A + (size_t)nxt.pm * tstep : cA; const char* nB = has_next ? (const char*)g.Bt + (size_t)nxt.pn * tstep : cB;
        for (int t = 0; t < nt; t += 2) {
            const bool last = (t == nt - 2);
            const char* a1 = cA + (size_t)(t + 1) * kstep;
            const char* a2 = last ? nA : cA + (size_t)(t + 2) * kstep; const char* b2 = last ? nB : cB + (size_t)(t + 2) * kstep;
            const char* a3 = a2 + kstep; const char* b3 = b2 + kstep;
            if (last && has_next) S.a_ready(nxt);
            if constexpr (SP2) {
            PG8_LDB(B0, 0, 0); PG8_LDB(B1, 0, 1); PG8_SCHED; PG8_LDA(At, 0, 0); PG8_STAGE(PG8_SA(1, 1), a1 + hstep, voffA);
            PG8_WAIT_V(8); PG8_WAIT_L(0); PG8_BAR; PG8_MMA(0, 0, At, B0); PG8_MMA(0, 1, At, B1); PG8_BAR; PG8_SCHED;
            PG8_LDA(At, 0, 1); PG8_STAGE(PG8_SB(0, 0), b2, voffB); PG8_STAGE(PG8_SB(0, 1), b2 + hstep, voffB); PG8_STAGE(PG8_SA(0, 0), a2, voffA);
            PG8_WAIT_V(8); PG8_WAIT_L(0); PG8_BAR; PG8_MMA(1, 0, At, B0); PG8_MMA(1, 1, At, B1); PG8_BAR; PG8_SCHED;
            PG8_LDB(B0, 1, 0); PG8_LDB(B1, 1, 1); PG8_SCHED; PG8_LDA(At, 1, 0); PG8_STAGE(PG8_SA(0, 1), a2 + hstep, voffA);
            PG8_WAIT_V(8); PG8_WAIT_L(0); PG8_BAR; PG8_MMA(0, 0, At, B0); PG8_MMA(0, 1, At, B1); PG8_BAR; PG8_SCHED;
            PG8_LDA(At, 1, 1); PG8_STAGE(PG8_SB(1, 0), b3, voffB); PG8_STAGE(PG8_SB(1, 1), b3 + hstep, voffB); PG8_STAGE(PG8_SA(1, 0), a3, voffA);
            PG8_WAIT_V(8); PG8_WAIT_L(0); PG8_BAR; PG8_MMA(1, 0, At, B0); PG8_MMA(1, 1, At, B1); PG8_BAR; PG8_SCHED;
            } else {
            PG8_LDB(B0, 0, 0); PG8_SCHED; PG8_LDA(At, 0, 0); PG8_STAGE(PG8_SA(1, 1), a1 + hstep, voffA);
            PG8_WAIT_L(8); PG8_BAR; PG8_WAIT_L(0); PG8_MMA(0, 0, At, B0); PG8_BAR; PG8_SCHED;
            PG8_LDB(B1, 0, 1); PG8_STAGE(PG8_SB(0, 0), b2, voffB);
            PG8_BAR; PG8_WAIT_L(0); PG8_MMA(0, 1, At, B1); PG8_BAR;
            PG8_LDA(At, 0, 1); PG8_STAGE(PG8_SA(0, 0), a2, voffA);
            PG8_BAR; PG8_WAIT_L(0); PG8_MMA(1, 0, At, B0); PG8_BAR; PG8_SCHED;
            PG8_STAGE(PG8_SB(0, 1), b2 + hstep, voffB);
            PG8_WAIT_V(6); PG8_BAR; PG8_MMA(1, 1, At, B1); PG8_BAR;
            PG8_LDB(B0, 1, 0); PG8_SCHED; PG8_LDA(At, 1, 0); PG8_STAGE(PG8_SA(0, 1), a2 + hstep, voffA);
            PG8_WAIT_L(8); PG8_BAR; PG8_WAIT_L(0); PG8_MMA(0, 0, At, B0); PG8_BAR; PG8_SCHED;
            PG8_LDB(B1, 1, 1); PG8_STAGE(PG8_SB(1, 0), b3, voffB);
            PG8_BAR; PG8_WAIT_L(0); PG8_MMA(0, 1, At, B1); PG8_BAR;
            PG8_LDA(At, 1, 1); PG8_STAGE(PG8_SA(1, 0), a3, voffA);
            PG8_BAR; PG8_WAIT_L(0); PG8_MMA(1, 0, At, B0); PG8_BAR; PG8_SCHED;
            PG8_STAGE(PG8_SB(1, 1), b3 + hstep, voffB);
            PG8_WAIT_V(6); PG8_BAR; PG8_MMA(1, 1, At, B1); PG8_BAR;
            }
        }
        if constexpr (ALIGN_EPI) { if (wr == 0) PG8_BAR; }
        if constexpr (!Epi::AFTER_DRAIN) { E(acc, cur, wr, wc, fr, fq); S.done(cur); }
        if (!has_next) break;
#pragma unroll
        for (int a = 0; a < 2; ++a)
#pragma unroll
            for (int b = 0; b < 2; ++b)
#pragma unroll
                for (int m = 0; m < 4; ++m)
#pragma unroll
                    for (int n = 0; n < 2; ++n) acc[a][b][m][n] = (f32x4){0.f, 0.f, 0.f, 0.f};
        cur = nxt; cA = nA; cB = nB; ++ui;
        if constexpr (ALIGN_EPI) { if (wr == 1) PG8_BAR; }
    }
    PG8_WAIT_V(0);
    if constexpr (!ALIGN_EPI) { if (wr == 0) PG8_BAR; }
    PG8_BAR;
    if constexpr (Epi::AFTER_DRAIN) { E.fused(acc, cur, wr, wc, fr, fq, lds, wid, lane); S.done(cur); }
#undef PG8_SA
#undef PG8_SB
#undef PG8_STAGE
#undef PG8_LDA
#undef PG8_LDB
#undef PG8_MMA
#undef PG8_WAIT_V
#undef PG8_WAIT_L
#undef PG8_BAR
#undef PG8_SCHED
}
}
constexpr int DM = 4096, SEQ = 256, LSEQ = 4096, DEPTH = 2;
constexpr int MC = 8192, M = 16384;
constexpr int DIN = 11264;
constexpr int A_Q = 0, A_K = 1024, A_V = 2048, A_G = 3072, B_Q = 4096, B_K = 5120, B_V = 5376, B_G = 5632, C_U = 6656, C_G = 7680, D_Q = 8704, D_K = 9728, D_V = 9984, D_G = 10240;
constexpr float LN_EPS = 1e-5f, RMS_EPS = 1e-6f, DN_ALPHA = 1.41421356237f;
constexpr size_t MiB = 1u << 20;
constexpr size_t WS_CTL = 0, CTL_ZERO_BYTES = 1 * MiB;
constexpr size_t WS_ADA = 1 * MiB;
constexpr size_t WS_ROPE = 2 * MiB;
constexpr size_t WS_ROPEA = 2 * MiB + 32768;
constexpr size_t WS_LAM = 2 * MiB + 65536;
constexpr size_t WS_S5A = 3 * MiB;
constexpr size_t WS_S5BB = 4 * MiB;
constexpr size_t WS_CAK = 8 * MiB, WS_CAV = 10 * MiB, WS_CBK = 12 * MiB, WS_CBV = 12 * MiB + 512 * 1024, WS_CDK = 13 * MiB, WS_CDV = 13 * MiB + 512 * 1024;
constexpr size_t WS_WIN = 16 * MiB;
constexpr size_t WS_WOUT = 192 * MiB;
constexpr size_t WS_GLU = 256 * MiB;
constexpr size_t WS_HM = 264 * MiB;
constexpr size_t WS_PROJ = 392 * MiB;
constexpr size_t WS_YACT = 744 * MiB;
constexpr size_t WS_YD = 776 * MiB;
constexpr size_t WS_XR = 904 * MiB;
constexpr size_t WS_SEG = 1156 * MiB;
constexpr size_t WS_ASCR = 1160 * MiB;
constexpr size_t WS_END = 1192 * MiB;
constexpr int CW_BAR = 4096;
constexpr size_t O_AK = (size_t)M * DM, O_AV = O_AK + 16777216, O_BK = O_AV + 16777216, O_BV = O_BK + 4194304, O_DK = O_BV + 4194304, O_DV = O_DK + 4194304, O_CRE = O_DV + 4194304, O_CIM = O_CRE + 524288, O_END = O_CIM + 524288;
constexpr int RING_OFF = 0, RING_BYTES = 131072;
constexpr int LDSCTL_OFF = RING_BYTES, MISC_OFF = LDSCTL_OFF + 320;
constexpr int LDS_BYTES = 147456;
constexpr int NWAVES = 8, NTHREADS = 512;

#define GAS __attribute__((address_space(1)))
#define LAS __attribute__((address_space(3)))
typedef unsigned short bf16;
typedef unsigned v4u __attribute__((ext_vector_type(4)));
typedef unsigned v2u __attribute__((ext_vector_type(2)));
typedef float f32x4 __attribute__((ext_vector_type(4)));
typedef GAS unsigned gu32;
#define RLX_AGENT __ATOMIC_RELAXED, __HIP_MEMORY_SCOPE_AGENT
#define LDS_WAIT() asm volatile("s_waitcnt lgkmcnt(0)" ::: "memory")
__device__ __forceinline__ unsigned f2bf(float f) { unsigned u = __builtin_bit_cast(unsigned, f); return (u + 0x7fffu + ((u >> 16) & 1u)) >> 16; }
__device__ __forceinline__ unsigned pk2(float lo, float hi) { unsigned r; asm("v_cvt_pk_bf16_f32 %0, %1, %2" : "=v"(r) : "v"(lo), "v"(hi)); return r; }
__device__ __forceinline__ float bf2f(bf16 b) { return __uint_as_float(((unsigned)b) << 16); }
__device__ __forceinline__ float blo(unsigned w) { return __uint_as_float(w << 16); }
__device__ __forceinline__ float bhi(unsigned w) { return __uint_as_float(w & 0xffff0000u); }
__device__ __forceinline__ float siluf(float x) { return x * __builtin_amdgcn_rcpf(1.f + __expf(-x)); }
__device__ __forceinline__ float gelu_tanh(float x) { const float u = 0.7978845608028654f * (x + 0.044715f * x * x * x); const float e = __expf(2.f * u); const float t = 1.f - 2.f * __builtin_amdgcn_rcpf(e + 1.f); return 0.5f * x * (1.f + t); }
template <int CTRL> __device__ __forceinline__ float dpp_f(float v) { return __builtin_bit_cast(float, __builtin_amdgcn_update_dpp(0, __builtin_bit_cast(int, v), CTRL, 0xF, 0xF, true)); }
__device__ __forceinline__ float red4(float v) { v += dpp_f<0xB1>(v); v += dpp_f<0x4E>(v); return v; }
__device__ __forceinline__ float red8(float v) { v = red4(v); v += dpp_f<0x141>(v); return v; }
__device__ __forceinline__ float red16(float v) { v = red8(v); v += dpp_f<0x140>(v); return v; }
__device__ __forceinline__ float red32(float v) { v = red16(v); v += __builtin_bit_cast(float, __builtin_amdgcn_ds_swizzle(__builtin_bit_cast(int, v), 0x401F)); return v; }
__device__ __forceinline__ float wave_sum(float v) { v = red32(v); const auto rr = __builtin_amdgcn_permlane32_swap(__float_as_uint(v), __float_as_uint(v), false, false); return __uint_as_float(rr[0]) + __uint_as_float(rr[1]); }
#define XB_TMO      128
#define XB_XCNT(j)  (256  + 64 * (j))
#define XB_XSUB(j)  (1280 + 64 * (j))
#define XB_XGEN(j)  (2304 + 64 * (j))
#define XB_TOP      3328
#define XB_TOPGEN   3392
#define XCD_BAR_WORDS 3456
#define XB_SPIN_CAP (1u << 18)

__device__ __forceinline__ unsigned xb_ld(unsigned* p)              { return __hip_atomic_load(p, __ATOMIC_RELAXED, __HIP_MEMORY_SCOPE_AGENT); }
__device__ __forceinline__ unsigned xb_add(unsigned* p, unsigned v) { return __hip_atomic_fetch_add(p, v, __ATOMIC_RELAXED, __HIP_MEMORY_SCOPE_AGENT); }
__device__ __forceinline__ unsigned xb_xcc_id() { return (unsigned)__builtin_amdgcn_s_getreg((3 << 11) | 20) & 0xFu; }
#define XB_SPIN(cond, bar) do { unsigned _sp = 0; while (cond) { __builtin_amdgcn_s_sleep(1); \
    if ((++_sp & 255u) == 0u) { if (xb_ld(&(bar)[XB_TMO])) break; if (_sp > XB_SPIN_CAP) { atomicAdd(&(bar)[XB_TMO], 1u); break; } } } } while (0)

struct XcdBarrier {
    unsigned* bar; unsigned x;
    volatile LAS unsigned* st;
};

__device__ __forceinline__ XcdBarrier xcd_barrier_post(unsigned* bar, volatile LAS unsigned* st, bool leader) {
    XcdBarrier b; b.bar = bar; b.x = xb_xcc_id(); b.st = st;
    if (leader) (void)xb_add(&bar[XB_XCNT(b.x)], 1u);
    return b;
}
__device__ __forceinline__ void xcd_barrier_complete(unsigned* bar, unsigned x, unsigned& nloc, unsigned& nx) {
    const unsigned G = gridDim.x * gridDim.y * gridDim.z;
    unsigned sum, cnt, mine, sp = 0u;
    for (;;) {
        sum = 0u; cnt = 0u; mine = 0u;
#pragma unroll
        for (unsigned j = 0; j < 16; ++j) { const unsigned c = xb_ld(&bar[XB_XCNT(j)]); sum += c; cnt += (c > 0u) ? 1u : 0u; mine = (j == x) ? c : mine; }
        if (sum == G) break;
        __builtin_amdgcn_s_sleep(1);
        if ((++sp & 255u) == 0u) { if (xb_ld(&bar[XB_TMO])) break; if (sp > XB_SPIN_CAP) { atomicAdd(&bar[XB_TMO], 1u); break; } }
    }
    nloc = mine > 0u ? mine : 1u; nx = cnt > 0u ? cnt : 1u;
}

__device__ __forceinline__ void xcd_barrier(const XcdBarrier& b, bool leader) {
    asm volatile("s_waitcnt vmcnt(0)" ::: "memory");
    __syncthreads();
    if (leader) {
        unsigned* bar = b.bar;
        __builtin_amdgcn_s_waitcnt(0);
        unsigned nloc = b.st[0], nx = b.st[1];
        if (nloc == 0u) { xcd_barrier_complete(bar, b.x, nloc, nx); b.st[0] = nloc; b.st[1] = nx; }
        const unsigned old = xb_add(&bar[XB_XSUB(b.x)], 1u);
        const unsigned gen = old / nloc;
        if (old + 1u == (gen + 1u) * nloc) {
            __builtin_amdgcn_fence(__ATOMIC_RELEASE, "agent");
            asm volatile("s_waitcnt vmcnt(0)" ::: "memory");
            const unsigned og = xb_add(&bar[XB_TOP], 1u);
            const unsigned tg = og / nx;
            if (og + 1u == (tg + 1u) * nx) xb_add(&bar[XB_TOPGEN], 1u);
            else XB_SPIN(xb_ld(&bar[XB_TOPGEN]) == tg, bar);
            __builtin_amdgcn_fence(__ATOMIC_ACQUIRE, "agent");
            xb_add(&bar[XB_XGEN(b.x)], 1u);
            asm volatile("s_waitcnt vmcnt(0)" ::: "memory");
        } else {
            XB_SPIN(xb_ld(&bar[XB_XGEN(b.x)]) == gen, bar);
            __builtin_amdgcn_fence(__ATOMIC_ACQUIRE, "agent");
            asm volatile("s_waitcnt vmcnt(0)" ::: "memory");
        }
    }
    __syncthreads();
}
enum { I_XP = 0, I_XS, I_C, I_CAK, I_CAV, I_CBK, I_CBV, I_CDK, I_CDV, I_SRE, I_SIM, I_CCTX, I_WADA, I_BADA, I_WIN, I_WOUT, I_LNG, I_LNB, I_LQ1, I_LK1, I_LQ2, I_LK2, I_SUBG, I_QNG, I_KNG, I_SINK,
       I_CLRE, I_CLIM, I_CLDT, I_CBRE, I_CBIM, I_CCRE, I_CCIM, I_CD, I_GLUW, I_GLUB, N_IN };
struct Args { const float* in[N_IN]; float* out; unsigned char* ws; };
typedef const __attribute__((address_space(4))) Args CArgs;

struct TItem { const float* W; bf16* WT; int K, N, k0, n0; };
__device__ __forceinline__ void p0_item_dma(const TItem& t, LAS unsigned char* img, int lane) {
    const float* src = t.W + (size_t)(t.k0 + (lane >> 3)) * t.N + t.n0;
#pragma unroll
    for (int i = 0; i < 8; ++i) __builtin_amdgcn_global_load_lds((const unsigned*)(src + (size_t)(8 * i) * t.N + 4 * ((lane & 7) ^ i)), (LAS unsigned*)(img + i * 1024), 16, 0, 0);
}
__device__ __forceinline__ void p0_item_store(const TItem& t, const LAS unsigned char* img, int lane) {
    const int c = lane & 7; const LAS float* s = (const LAS float*)img + (8 * c) * 32;
#pragma unroll
    for (int j = 0; j < 4; ++j) { const int n = (lane >> 3) + 8 * j, o4 = (((n >> 2) ^ c) << 2) + (n & 3);
        v4u o; o.x = pk2(s[0 * 32 + o4], s[1 * 32 + o4]); o.y = pk2(s[2 * 32 + o4], s[3 * 32 + o4]); o.z = pk2(s[4 * 32 + o4], s[5 * 32 + o4]); o.w = pk2(s[6 * 32 + o4], s[7 * 32 + o4]);
        *(GAS v4u*)(t.WT + (size_t)(t.n0 + n) * t.K + t.k0 + 8 * c) = o; }
}
__device__ __forceinline__ void cvt_copy(const float* src, bf16* dst, size_t n8, size_t i0, size_t stride) {
    for (size_t i = i0; i < n8; i += stride) { const f32x4 a = *(const f32x4*)(src + 8 * i), b = *(const f32x4*)(src + 8 * i + 4);
        v4u o; o.x = pk2(a.x, a.y); o.y = pk2(a.z, a.w); o.z = pk2(b.x, b.y); o.w = pk2(b.z, b.w); *(v4u*)(dst + 8 * i) = o; }
}
__device__ __forceinline__ void p0_ada(CArgs& a, LAS unsigned char* lds, int wv) {
    int tid = tid_of(wv); asm volatile("" : "+v"(tid));
    unsigned char* ws = a.ws;
    {
        LAS float* S = (LAS float*)lds;
        LAS float* red = S + 3 * 4096;
        for (int i = tid; i < 3 * 4096; i += NTHREADS) { const int v = i >> 12, k = i & 4095; const float x = v == 0 ? a.in[I_CCTX][k] : a.in[I_C][(v - 1) * 4096 + k]; S[i] = siluf(x); }
        __syncthreads();
        const int q = tid % 24, ks = tid / 24;
        for (int grp = blockIdx.x; grp < 256; grp += gridDim.x) {
            const int l = grp >> 7, n0 = (grp & 127) * 96;
            f32x4 acc0 = {0.f, 0.f, 0.f, 0.f}, acc1 = acc0, acc2 = acc0;
            if (ks < 21) {
                const float* wp = a.in[I_WADA] + (size_t)l * 4096 * 12288 + n0 + 4 * q;
#pragma unroll 8
                for (int k = ks; k < 4096; k += 21) { const f32x4 w = *(const f32x4*)(wp + (size_t)k * 12288); acc0 += w * S[k]; acc1 += w * S[4096 + k]; acc2 += w * S[8192 + k]; }
                LAS float* r = red + (ks * 24 + q) * 12;
#pragma unroll
                for (int j = 0; j < 4; ++j) { r[j] = acc0[j]; r[4 + j] = acc1[j]; r[8 + j] = acc2[j]; }
            }
            __syncthreads();
            if (tid < 288) { const int v = tid / 96, c = tid % 96, qq = c >> 2, j = c & 3; float s = 0.f;
                for (int k2 = 0; k2 < 21; ++k2) s += red[(k2 * 24 + qq) * 12 + v * 4 + j];
                ((float*)(ws + WS_ADA))[(size_t)(l * 3 + v) * 12288 + n0 + c] = s + a.in[I_BADA][(size_t)l * 12288 + n0 + c]; }
            __syncthreads();
        }
    }
}
__device__ __forceinline__ void p0_prologue(CArgs& a, LAS unsigned char* lds, int wv) {
    int tid = tid_of(wv); asm volatile("" : "+v"(tid)); const int lane = tid & 63, wave = __builtin_amdgcn_readfirstlane(tid >> 6);
    const int gw = blockIdx.x * NWAVES + wave, NGW = gridDim.x * NWAVES;
    unsigned char* ws = a.ws;
    {
        LAS unsigned char* img = lds + wave * 16384;
        constexpr int I_IN = (DM / 64) * (DIN / 32), I_OUT = (DM / 64) * (DM / 32), I_GL = (1024 / 64) * (1024 / 32), I_L = I_IN + I_OUT + I_GL;
        auto decode = [&](int it) -> TItem { const int l = it / I_L; int r = it % I_L;
            if (r < I_IN) { const int nblk = DIN / 32; return TItem{a.in[I_WIN] + (size_t)l * DM * DIN, (bf16*)(ws + WS_WIN) + (size_t)l * DIN * DM, DM, DIN, 64 * (r / nblk), 32 * (r % nblk)}; } r -= I_IN;
            if (r < I_OUT) { const int nblk = DM / 32; return TItem{a.in[I_WOUT] + (size_t)l * DM * DM, (bf16*)(ws + WS_WOUT) + (size_t)l * DM * DM, DM, DM, 64 * (r / nblk), 32 * (r % nblk)}; } r -= I_OUT;
            const int nblk = 1024 / 32; return TItem{a.in[I_GLUW] + (size_t)l * 1024 * 1024, (bf16*)(ws + WS_GLU) + (size_t)l * 1024 * 1024, 1024, 1024, 64 * (r / nblk), 32 * (r % nblk)}; };
        int it = gw, par = 0;
        if (it < 2 * I_L) p0_item_dma(decode(it), img, lane);
        for (; it < 2 * I_L; it += NGW, par ^= 1) {
            const bool more = it + NGW < 2 * I_L;
            if (more) { p0_item_dma(decode(it + NGW), img + (par ^ 1) * 8192, lane); asm volatile("s_waitcnt vmcnt(8)" ::: "memory"); }
            else asm volatile("s_waitcnt vmcnt(0)" ::: "memory");
            p0_item_store(decode(it), img + par * 8192, lane);
            asm volatile("s_waitcnt lgkmcnt(0)" ::: "memory");
        }
    }
    {
        const size_t gt = (size_t)blockIdx.x * NTHREADS + tid, NGT = (size_t)gridDim.x * NTHREADS;
        cvt_copy(a.in[I_CAK], (bf16*)(ws + WS_CAK), 1048576 / 8, gt, NGT); cvt_copy(a.in[I_CAV], (bf16*)(ws + WS_CAV), 1048576 / 8, gt, NGT);
        cvt_copy(a.in[I_CBK], (bf16*)(ws + WS_CBK), 262144 / 8, gt, NGT);  cvt_copy(a.in[I_CBV], (bf16*)(ws + WS_CBV), 262144 / 8, gt, NGT);
        cvt_copy(a.in[I_CDK], (bf16*)(ws + WS_CDK), 262144 / 8, gt, NGT);  cvt_copy(a.in[I_CDV], (bf16*)(ws + WS_CDV), 262144 / 8, gt, NGT);
        float* rope = (float*)(ws + WS_ROPE);
        for (size_t i = gt; i < 2048; i += NGT) { const int pos = (int)(i >> 5), fi = (int)(i & 31); const float inv = exp2f(-(float)fi * (13.287712379549449f / 32.f)); const float ang = (float)pos * inv; rope[2 * i] = cosf(ang); rope[2 * i + 1] = sinf(ang); }
        { float* ropea = (float*)(ws + WS_ROPEA);
          for (size_t i = gt; i < 1024; i += NGT) { const int pos = (int)(i >> 4), fi = (int)(i & 15); const float inv = exp2f(-(float)fi * (13.287712379549449f / 16.f)); const float ang = (float)pos * inv; ropea[2 * i] = cosf(ang); ropea[2 * i + 1] = sinf(ang); } }
        float* sa_re = (float*)(ws + WS_S5A); float* sa_im = sa_re + 16384; float* sbb_re = (float*)(ws + WS_S5BB); float* sbb_im = sbb_re + 262144;
        for (size_t i = gt; i < 16384; i += NGT) {
            const float lr = a.in[I_CLRE][i], li = a.in[I_CLIM][i], dt = expf(a.in[I_CLDT][i >> 6]);
            const float mag = expf(lr * dt), th = li * dt, cs = cosf(th), sn = sinf(th);
            const float are = mag * cs, aim = mag * sn;
            const float sh = sinf(0.5f * th); const float nr = expm1f(lr * dt) * cs - 2.f * sh * sh;
            const float den = lr * lr + li * li;
            const float fre = (nr * lr + aim * li) / den, fim = (aim * lr - nr * li) / den;
            sa_re[i] = are; sa_im[i] = aim;
#pragma unroll
            for (int c = 0; c < 16; ++c) { const float br = a.in[I_CBRE][i * 16 + c], bi = a.in[I_CBIM][i * 16 + c]; sbb_re[i * 16 + c] = fre * br - fim * bi; sbb_im[i * 16 + c] = fre * bi + fim * br; }
        }
        if (gt < 2) { const int l = (int)gt; float s1 = 0.f, s2 = 0.f;
            for (int k = 0; k < 64; ++k) { s1 += a.in[I_LQ1][l * 64 + k] * a.in[I_LK1][l * 64 + k]; s2 += a.in[I_LQ2][l * 64 + k] * a.in[I_LK2][l * 64 + k]; }
            const float lam_init = l == 0 ? 0.2f : 0.35550906759f;
            ((float*)(ws + WS_LAM))[l] = expf(s1) - expf(s2) + lam_init; }
    }
}
__device__ __forceinline__ void row_norm16(f32x4 (&v)[16]) {
    float s = 0.f;
#pragma unroll
    for (int j = 0; j < 16; ++j) s += (v[j].x + v[j].y) + (v[j].z + v[j].w);
    const float mean = wave_sum(s) * (1.f / DM); float s2 = 0.f;
#pragma unroll
    for (int j = 0; j < 16; ++j) { v[j] = v[j] - mean; s2 += (v[j].x * v[j].x + v[j].y * v[j].y) + (v[j].z * v[j].z + v[j].w * v[j].w); }
    const float rstd = 1.f / sqrtf(wave_sum(s2) * (1.f / DM) + LN_EPS);
#pragma unroll
    for (int j = 0; j < 16; ++j) v[j] = v[j] * rstd;
}
__device__ __forceinline__ void row_ld_bf16(const bf16* row, int lane, f32x4 (&v)[16]) {
    const v2u* p = (const v2u*)row + lane;
#pragma unroll
    for (int j = 0; j < 16; ++j) { const v2u w = p[64 * j]; v[j] = (f32x4){blo(w.x), bhi(w.x), blo(w.y), bhi(w.y)}; }
}
__device__ __forceinline__ void row_st_bf16(bf16* row, int lane, const f32x4 (&v)[16]) {
    v2u* p = (v2u*)row + lane;
#pragma unroll
    for (int j = 0; j < 16; ++j) { v2u w; w.x = pk2(v[j].x, v[j].y); w.y = pk2(v[j].z, v[j].w); p[64 * j] = w; }
}
__device__ __forceinline__ void ln_mod_row(const float* xrow, const float* ada_v, bf16* hrow, int lane) {
    const f32x4* xr = (const f32x4*)xrow + lane; f32x4 v[16];
#pragma unroll
    for (int j = 0; j < 16; ++j) v[j] = xr[64 * j];
    row_norm16(v);
#pragma unroll
    for (int j = 0; j < 16; ++j) { const int col = 4 * (lane + 64 * j); v[j] = v[j] * (*(const f32x4*)(ada_v + 4096 + col) + 1.f) + *(const f32x4*)(ada_v + col); }
    row_st_bf16(hrow, lane, v);
}
__device__ __forceinline__ void ln_final_row(const bf16* xrow, const float* g, const float* b, float* orow, int lane) {
    f32x4 v[16]; row_ld_bf16(xrow, lane, v); row_norm16(v);
    f32x4* o = (f32x4*)orow + lane;
#pragma unroll
    for (int j = 0; j < 16; ++j) { const int col = 4 * (lane + 64 * j); o[64 * j] = v[j] * *(const f32x4*)(g + col) + *(const f32x4*)(b + col); }
}
__device__ __forceinline__ void ln_final_mod_row(const bf16* xrow, const float* g, const float* b, bf16* orow, const float* ada_v, bf16* hrow, int lane) {
    f32x4 v[16]; row_ld_bf16(xrow, lane, v); row_norm16(v);
#pragma unroll
    for (int j = 0; j < 16; ++j) { const int col = 4 * (lane + 64 * j); v[j] = v[j] * *(const f32x4*)(g + col) + *(const f32x4*)(b + col); }
    row_st_bf16(orow, lane, v);
    row_norm16(v);
#pragma unroll
    for (int j = 0; j < 16; ++j) { const int col = 4 * (lane + 64 * j); v[j] = v[j] * (*(const f32x4*)(ada_v + 4096 + col) + 1.f) + *(const f32x4*)(ada_v + col); }
    row_st_bf16(hrow, lane, v);
}
template <int NI> __device__ __forceinline__ void row_dma(const void* row, LAS unsigned char* buf, int lane) {
#pragma unroll
    for (int i = 0; i < NI; ++i) __builtin_amdgcn_global_load_lds((const unsigned*)((const char*)row + i * 1024 + lane * 16), (LAS unsigned*)(buf + i * 1024), 16, 0, 0);
}
__device__ __forceinline__ void row_lds_f32(const LAS unsigned char* buf, int lane, f32x4 (&r)[16]) { const LAS f32x4* p = (const LAS f32x4*)buf + lane;
#pragma unroll
    for (int j = 0; j < 16; ++j) r[j] = p[64 * j]; }
__device__ __forceinline__ void row_lds_bf16(const LAS unsigned char* buf, int lane, v2u (&r)[16]) { const LAS v2u* p = (const LAS v2u*)buf + lane;
#pragma unroll
    for (int j = 0; j < 16; ++j) r[j] = p[64 * j]; }
__device__ __forceinline__ void row_cvt16(const v2u (&r)[16], f32x4 (&v)[16]) {
#pragma unroll
    for (int j = 0; j < 16; ++j) v[j] = (f32x4){blo(r[j].x), bhi(r[j].x), blo(r[j].y), bhi(r[j].y)}; }
__device__ __forceinline__ void ln_mod_apply(f32x4 (&v)[16], const float* ada_v, bf16* hrow, int lane) {
    row_norm16(v);
#pragma unroll
    for (int j = 0; j < 16; ++j) { const int col = 4 * (lane + 64 * j); v[j] = v[j] * (*(const f32x4*)(ada_v + 4096 + col) + 1.f) + *(const f32x4*)(ada_v + col); }
    row_st_bf16(hrow, lane, v);
}
__device__ __forceinline__ void ln_final_apply(const v2u (&r)[16], const float* g, const float* b, float* orow, int lane) {
    f32x4 v[16]; row_cvt16(r, v); row_norm16(v);
    f32x4* o = (f32x4*)orow + lane;
#pragma unroll
    for (int j = 0; j < 16; ++j) { const int col = 4 * (lane + 64 * j); o[64 * j] = v[j] * *(const f32x4*)(g + col) + *(const f32x4*)(b + col); }
}
__device__ __forceinline__ void ln_final_mod_apply(const v2u (&r)[16], const float* g, const float* b, bf16* orow, const float* ada_v, bf16* hrow, int lane) {
    f32x4 v[16]; row_cvt16(r, v); row_norm16(v);
#pragma unroll
    for (int j = 0; j < 16; ++j) { const int col = 4 * (lane + 64 * j); v[j] = v[j] * *(const f32x4*)(g + col) + *(const f32x4*)(b + col); }
    row_st_bf16(orow, lane, v);
    row_norm16(v);
#pragma unroll
    for (int j = 0; j < 16; ++j) { const int col = 4 * (lane + 64 * j); v[j] = v[j] * (*(const f32x4*)(ada_v + 4096 + col) + 1.f) + *(const f32x4*)(ada_v + col); }
    row_st_bf16(hrow, lane, v);
}
__device__ __forceinline__ const float* x_row_in(CArgs& a, int m) { return m < MC ? a.in[I_XP] + (size_t)m * DM : a.in[I_XS] + (size_t)(m - MC) * DM; }
__device__ __forceinline__ int cond_of_row(int m) { return m < MC ? 0 : 1 + ((m - MC) >> 12); }

__device__ __forceinline__ void unpack8(const v4u w, float (&x)[8]) { x[0] = blo(w.x); x[1] = bhi(w.x); x[2] = blo(w.y); x[3] = bhi(w.y); x[4] = blo(w.z); x[5] = bhi(w.z); x[6] = blo(w.w); x[7] = bhi(w.w); }
__device__ __forceinline__ v4u pack8(const float (&x)[8]) { v4u w; w.x = pk2(x[0], x[1]); w.y = pk2(x[2], x[3]); w.z = pk2(x[4], x[5]); w.w = pk2(x[6], x[7]); return w; }
__device__ __forceinline__ void rope8(float (&x0)[8], float (&x1)[8], const float (&cs)[16]) {
#pragma unroll
    for (int t = 0; t < 8; ++t) { const float c = cs[2 * t], s = cs[2 * t + 1], y0 = x0[t] * c - x1[t] * s, y1 = x1[t] * c + x0[t] * s; x0[t] = y0; x1[t] = y1; }
}
__device__ __forceinline__ void load16f(const float* p, float (&v)[16]) {
#pragma unroll
    for (int q = 0; q < 4; ++q) { const f32x4 t = *(const f32x4*)(p + 4 * q); v[4 * q] = t.x; v[4 * q + 1] = t.y; v[4 * q + 2] = t.z; v[4 * q + 3] = t.w; }
}
__device__ __forceinline__ void cvt_out8(const bf16* src, float* dst) { const v4u w = *(const v4u*)src; *(f32x4*)dst = (f32x4){blo(w.x), bhi(w.x), blo(w.y), bhi(w.y)}; *(f32x4*)(dst + 4) = (f32x4){blo(w.z), bhi(w.z), blo(w.w), bhi(w.w)}; }
__device__ __forceinline__ void post_touch(CArgs& a, int m, int lane, LAS unsigned char* dummy) {
    const bf16* pr = (const bf16*)(a.ws + WS_PROJ) + (size_t)m * DIN;
    if (m < MC) { const int col = lane < 32 ? A_K + lane * 64 : lane < 56 ? B_Q + (lane - 32) * 64 : D_K + (lane - 56) * 64; __builtin_amdgcn_global_load_lds((const unsigned*)(pr + col), (LAS unsigned*)dummy, 4, 0, 0); }
    else { const int col = lane < 32 ? A_Q + lane * 64 : lane < 52 ? B_Q + (lane - 32) * 64 : D_Q + (lane - 52) * 64; __builtin_amdgcn_global_load_lds((const unsigned*)(pr + col), (LAS unsigned*)dummy, 4, 0, 0);
           }
}
__device__ __forceinline__ void post_row(CArgs& a, int l, int m, int lane) {
    bf16* pr = (bf16*)(a.ws + WS_PROJ) + (size_t)m * DIN;
    const float* qg = a.in[I_QNG] + l * 128; const float* kg = a.in[I_KNG] + l * 128;
    const int hh = lane >> 3, sub = lane & 7;
    if (m < MC) {
        const int b = m >> 8, n = m & 255; const size_t r1 = ((size_t)(b * 2 + l) * 256 + n);
        float* o_ak = a.out + O_AK + r1 * 1024; float* o_av = a.out + O_AV + r1 * 1024;
#pragma unroll
        for (int j = 0; j < 2; ++j) { const int e = (lane + 64 * j) * 8; cvt_out8(pr + A_K + e, o_ak + e); cvt_out8(pr + A_V + e, o_av + e); }
        float* o_bk = a.out + O_BK + r1 * 256; float* o_bv = a.out + O_BV + r1 * 256; float* o_dk = a.out + O_DK + r1 * 256; float* o_dv = a.out + O_DV + r1 * 256;
        if (lane < 32) { const int e = lane * 8; cvt_out8(pr + B_V + e, o_bv + e); cvt_out8(pr + D_K + e, o_dk + e); cvt_out8(pr + D_V + e, o_dv + e); }
#pragma unroll
        for (int pass = 0; pass < 2; ++pass) {
            const bool act = pass == 0 || lane < 16; const int hq = pass == 0 ? hh : (hh & 1);
            bf16* hp = pr + (pass == 0 ? B_Q : B_K) + hq * 128 + sub * 16; const float* g = (pass == 0 ? qg : kg) + sub * 16;
            float x0[8], x1[8], g16[16]; unpack8(*(const v4u*)hp, x0); unpack8(*(const v4u*)(hp + 8), x1); load16f(g, g16);
            float ss = 0.f;
#pragma unroll
            for (int t = 0; t < 8; ++t) ss += x0[t] * x0[t] + x1[t] * x1[t];
            ss = red8(ss);
            const float r = 1.f / sqrtf(ss * (1.f / 128.f) + RMS_EPS);
#pragma unroll
            for (int t = 0; t < 8; ++t) { x0[t] = x0[t] * r * g16[t]; x1[t] = x1[t] * r * g16[8 + t]; }
            if (act) { *(v4u*)hp = pack8(x0); *(v4u*)(hp + 8) = pack8(x1);
                if (pass == 1) { float* ob = o_bk + hq * 128 + sub * 16; *(f32x4*)ob = (f32x4){x0[0], x0[1], x0[2], x0[3]}; *(f32x4*)(ob + 4) = (f32x4){x0[4], x0[5], x0[6], x0[7]};
                    *(f32x4*)(ob + 8) = (f32x4){x1[0], x1[1], x1[2], x1[3]}; *(f32x4*)(ob + 12) = (f32x4){x1[4], x1[5], x1[6], x1[7]}; } }
        }
    } else {
        const int n = (m - MC) & 4095, rr = n >> 6, cc = n & 63;
        { const int ha = lane >> 2, sa = lane & 3, half = sa >> 1, j = sa & 1; float cs[16]; load16f((const float*)(a.ws + WS_ROPEA) + ((half ? cc : rr) * 16 + j * 8) * 2, cs);
#pragma unroll
            for (int t2 = 0; t2 < 2; ++t2) { bf16* hp = pr + (t2 ? A_K : A_Q) + ha * 64 + half * 32 + j * 8; float x0[8], x1[8]; unpack8(*(const v4u*)hp, x0); unpack8(*(const v4u*)(hp + 16), x1);
                rope8(x0, x1, cs); *(v4u*)hp = pack8(x0); *(v4u*)(hp + 16) = pack8(x1); } }
        { const int half = sub >> 2, j = sub & 3; float cs[16]; load16f((const float*)(a.ws + WS_ROPE) + ((half ? cc : rr) * 32 + j * 8) * 2, cs);
#pragma unroll
            for (int pass = 0; pass < 3; ++pass) {
                const bool act = pass < 2 || lane < 32; const bool isB = pass == 0 || (pass == 2 && lane < 16); const int hq = pass < 2 ? hh : (hh & 1);
                bf16* hp = pr + (pass == 0 ? B_Q : pass == 1 ? D_Q : (lane < 16 ? B_K : D_K)) + hq * 128 + half * 64 + j * 8;
                const float* g = (pass == 0 ? qg : kg) + half * 64 + j * 8;
                float x0[8], x1[8]; unpack8(*(const v4u*)hp, x0); unpack8(*(const v4u*)(hp + 32), x1);
                float ss = 0.f;
#pragma unroll
                for (int t = 0; t < 8; ++t) ss += x0[t] * x0[t] + x1[t] * x1[t];
                ss = red8(ss);
                if (isB) { const float r = 1.f / sqrtf(ss * (1.f / 128.f) + RMS_EPS); const f32x4 ga = *(const f32x4*)g, gb = *(const f32x4*)(g + 4), gc = *(const f32x4*)(g + 32), gd = *(const f32x4*)(g + 36);
                    const float g0[8] = {ga.x, ga.y, ga.z, ga.w, gb.x, gb.y, gb.z, gb.w}, g1[8] = {gc.x, gc.y, gc.z, gc.w, gd.x, gd.y, gd.z, gd.w};
#pragma unroll
                    for (int t = 0; t < 8; ++t) { x0[t] = x0[t] * r * g0[t]; x1[t] = x1[t] * r * g1[t]; } }
                rope8(x0, x1, cs);
                if (act) { *(v4u*)hp = pack8(x0); *(v4u*)(hp + 32) = pack8(x1); }
            } }
    }
}
namespace fa {
using bf16x8 = __attribute__((ext_vector_type(8))) short;
using s16x4  = __attribute__((ext_vector_type(4))) short;
using f32x16 = __attribute__((ext_vector_type(16))) float;
using u32x4  = __attribute__((ext_vector_type(4))) unsigned;
typedef LAS char* lptr;
constexpr int KVBLK = 64;
constexpr int SHM_V = 64 * 128 * 2, SHM_K = 64 * 128 * 2, SHM_ATTN = 2 * SHM_V + 2 * SHM_K + 8 * 64 * 4;
constexpr float THR = 8.f;
#define FA_KSWZ(row, colB) ((row) * 256 + ((colB) ^ (((row) & 7) << 4)))
#define FA_KSWZ64(row, colB) ((row) * 128 + ((colB) ^ ((((row) >> 1) & 7) << 4)))
#define FA_SBAR() __builtin_amdgcn_sched_barrier(0)
__device__ __forceinline__ int crow(int r, int hi) { return (r & 3) + 8 * (r >> 2) + 4 * hi; }
__device__ __forceinline__ unsigned cvtpk(float lo, float hi) { unsigned r; asm volatile("v_cvt_pk_bf16_f32 %0, %1, %2" : "=v"(r) : "v"(lo), "v"(hi)); return r; }
template <int DQK> struct Sc { static constexpr float SCALE = DQK == 128 ? 0.088388347648318440f : 0.125f; };

template <int DQK>
__device__ __forceinline__ void partialSM(f32x16& p0, f32x16& p1, float& m_reg, float& mn, float& alpha) {
  constexpr float SCALE = Sc<DQK>::SCALE, C = SCALE * 1.4426950408889634f;
  float pmax = p0[0];
#pragma unroll
  for (int r = 1; r < 16; ++r) pmax = fmaxf(pmax, p0[r]);
#pragma unroll
  for (int r = 0; r < 16; ++r) pmax = fmaxf(pmax, p1[r]);
  { auto rr = __builtin_amdgcn_permlane32_swap(__float_as_uint(pmax), __float_as_uint(pmax), false, false);
    pmax = fmaxf(__uint_as_float(rr[0]), __uint_as_float(rr[1])); }
  if (__builtin_expect(__all(pmax - m_reg <= THR / SCALE), 1)) { mn = m_reg; alpha = 1.f; }
  else { mn = fmaxf(m_reg, pmax); alpha = __builtin_amdgcn_exp2f((m_reg - mn) * C); m_reg = mn; }
  const float mnC = -mn * C;
#pragma unroll
  for (int r = 0; r < 16; ++r) p0[r] = fmaf(p0[r], C, mnC);
#pragma unroll
  for (int r = 0; r < 16; ++r) p1[r] = fmaf(p1[r], C, mnC);
#pragma unroll
  for (int r = 0; r < 16; ++r) p0[r] = __builtin_amdgcn_exp2f(p0[r]);
}
__device__ __forceinline__ void finishSM(f32x16& p0, f32x16& p1, float alpha, float& l_reg, bf16x8& pa0, bf16x8& pa1, bf16x8& pa2, bf16x8& pa3) {
#pragma unroll
  for (int r = 0; r < 16; ++r) p1[r] = __builtin_amdgcn_exp2f(p1[r]);
  float ps = 0;
#pragma unroll
  for (int r = 0; r < 16; ++r) ps += p0[r];
#pragma unroll
  for (int r = 0; r < 16; ++r) ps += p1[r];
  { auto rr = __builtin_amdgcn_permlane32_swap(__float_as_uint(ps), __float_as_uint(ps), false, false);
    ps = __uint_as_float(rr[0]) + __uint_as_float(rr[1]); }
  l_reg = l_reg * alpha + ps;
#define FA_PK4(P, BASE, OUT) do { unsigned a0 = cvtpk(P[BASE + 0], P[BASE + 1]), a1 = cvtpk(P[BASE + 2], P[BASE + 3]);   \
    unsigned b0 = cvtpk(P[BASE + 4], P[BASE + 5]), b1 = cvtpk(P[BASE + 6], P[BASE + 7]);                              \
    auto r0 = __builtin_amdgcn_permlane32_swap(a0, b0, false, false); auto r1 = __builtin_amdgcn_permlane32_swap(a1, b1, false, false); \
    u32x4 w = {r0[0], r1[0], r0[1], r1[1]}; OUT = __builtin_bit_cast(bf16x8, w); } while (0)
  FA_PK4(p0, 0, pa0); FA_PK4(p0, 8, pa1); FA_PK4(p1, 0, pa2); FA_PK4(p1, 8, pa3);
#undef FA_PK4
}
template <int DQK>
__device__ __forceinline__ void qkt(f32x16& p0, f32x16& p1, lptr Ks, const bf16x8* qr, int r32, int hi) {
  p0 = f32x16{}; p1 = f32x16{};
#pragma unroll
  for (int d0 = 0; d0 < DQK / 16; ++d0) { const int cb = (d0 * 16 + hi * 8) * 2;
    const bf16x8 b0 = *(const LAS bf16x8*)(Ks + (DQK == 128 ? FA_KSWZ(r32, cb) : FA_KSWZ64(r32, cb)));
    const bf16x8 b1 = *(const LAS bf16x8*)(Ks + (DQK == 128 ? FA_KSWZ(32 + r32, cb) : FA_KSWZ64(32 + r32, cb)));
    p0 = __builtin_amdgcn_mfma_f32_32x32x16_bf16(b0, qr[d0], p0, 0, 0, 0);
    p1 = __builtin_amdgcn_mfma_f32_32x32x16_bf16(b1, qr[d0], p1, 0, 0, 0); }
}
__device__ __forceinline__ void band_mask(f32x16& p0, f32x16& p1, int kpos0, int qpos, int hi) {
#pragma unroll
  for (int r = 0; r < 16; ++r) { const int d0 = kpos0 + crow(r, hi) - qpos, d1 = d0 + 32;
    p0[r] = (d0 > 128 || d0 < -128) ? -1e30f : p0[r]; p1[r] = (d1 > 128 || d1 < -128) ? -1e30f : p1[r]; }
}
__device__ __forceinline__ int v_st(int k, int c) { const int kk = (k & ~0xC) | ((k & 4) << 1) | ((k & 8) >> 1); return ((kk >> 3) * 4 + (c >> 5)) * 512 + ((kk & 7) * 32 + (c & 31)) * 2; }
__device__ __forceinline__ int v_rd_base(int lane) { return ((lane & 3) << 3) | (((lane >> 2) & 3) << 6) | (((lane >> 4) & 1) << 5) | (((lane >> 5) & 1) << 8); }
constexpr int v_rd_off(int d0, int ks, int half) { return d0 * 512 + ks * 4096 + half * 2048; }
template <int OFF> __device__ __forceinline__ s16x4 tr_read(int vb) {
  s16x4 r; asm volatile("ds_read_b64_tr_b16 %0, %1 offset:%2" : "=&v"(r) : "v"(vb), "i"(OFF) : "memory"); return r;
}
template <int D0> __device__ __forceinline__ void pv_one(f32x16& od, int vb, bf16x8 pa0, bf16x8 pa1, bf16x8 pa2, bf16x8 pa3) {
  const s16x4 l0 = tr_read<v_rd_off(D0, 0, 0)>(vb), h0 = tr_read<v_rd_off(D0, 0, 1)>(vb), l1 = tr_read<v_rd_off(D0, 1, 0)>(vb), h1 = tr_read<v_rd_off(D0, 1, 1)>(vb);
  const s16x4 l2 = tr_read<v_rd_off(D0, 2, 0)>(vb), h2 = tr_read<v_rd_off(D0, 2, 1)>(vb), l3 = tr_read<v_rd_off(D0, 3, 0)>(vb), h3 = tr_read<v_rd_off(D0, 3, 1)>(vb);
  asm volatile("s_waitcnt lgkmcnt(0)" ::: "memory"); FA_SBAR();
#define FA_PK(L, H) (bf16x8){L[0], L[1], L[2], L[3], H[0], H[1], H[2], H[3]}
  od = __builtin_amdgcn_mfma_f32_32x32x16_bf16(pa0, FA_PK(l0, h0), od, 0, 0, 0);
  od = __builtin_amdgcn_mfma_f32_32x32x16_bf16(pa1, FA_PK(l1, h1), od, 0, 0, 0);
  od = __builtin_amdgcn_mfma_f32_32x32x16_bf16(pa2, FA_PK(l2, h2), od, 0, 0, 0);
  od = __builtin_amdgcn_mfma_f32_32x32x16_bf16(pa3, FA_PK(l3, h3), od, 0, 0, 0);
#undef FA_PK
}
template <int DA, int DB> __device__ __forceinline__ void pv_two(f32x16& oa, f32x16& ob, int vb, bf16x8 pa0, bf16x8 pa1, bf16x8 pa2, bf16x8 pa3) {
  const s16x4 al0 = tr_read<v_rd_off(DA, 0, 0)>(vb), ah0 = tr_read<v_rd_off(DA, 0, 1)>(vb), bl0 = tr_read<v_rd_off(DB, 0, 0)>(vb), bh0 = tr_read<v_rd_off(DB, 0, 1)>(vb);
  const s16x4 al1 = tr_read<v_rd_off(DA, 1, 0)>(vb), ah1 = tr_read<v_rd_off(DA, 1, 1)>(vb), bl1 = tr_read<v_rd_off(DB, 1, 0)>(vb), bh1 = tr_read<v_rd_off(DB, 1, 1)>(vb);
  const s16x4 al2 = tr_read<v_rd_off(DA, 2, 0)>(vb), ah2 = tr_read<v_rd_off(DA, 2, 1)>(vb), bl2 = tr_read<v_rd_off(DB, 2, 0)>(vb), bh2 = tr_read<v_rd_off(DB, 2, 1)>(vb);
  const s16x4 al3 = tr_read<v_rd_off(DA, 3, 0)>(vb), ah3 = tr_read<v_rd_off(DA, 3, 1)>(vb), bl3 = tr_read<v_rd_off(DB, 3, 0)>(vb), bh3 = tr_read<v_rd_off(DB, 3, 1)>(vb);
  asm volatile("s_waitcnt lgkmcnt(0)" ::: "memory"); FA_SBAR();
#define FA_PK(L, H) (bf16x8){L[0], L[1], L[2], L[3], H[0], H[1], H[2], H[3]}
  oa = __builtin_amdgcn_mfma_f32_32x32x16_bf16(pa0, FA_PK(al0, ah0), oa, 0, 0, 0); ob = __builtin_amdgcn_mfma_f32_32x32x16_bf16(pa0, FA_PK(bl0, bh0), ob, 0, 0, 0);
  oa = __builtin_amdgcn_mfma_f32_32x32x16_bf16(pa1, FA_PK(al1, ah1), oa, 0, 0, 0); ob = __builtin_amdgcn_mfma_f32_32x32x16_bf16(pa1, FA_PK(bl1, bh1), ob, 0, 0, 0);
  oa = __builtin_amdgcn_mfma_f32_32x32x16_bf16(pa2, FA_PK(al2, ah2), oa, 0, 0, 0); ob = __builtin_amdgcn_mfma_f32_32x32x16_bf16(pa2, FA_PK(bl2, bh2), ob, 0, 0, 0);
  oa = __builtin_amdgcn_mfma_f32_32x32x16_bf16(pa3, FA_PK(al3, ah3), oa, 0, 0, 0); ob = __builtin_amdgcn_mfma_f32_32x32x16_bf16(pa3, FA_PK(bl3, bh3), ob, 0, 0, 0);
#undef FA_PK
}
__device__ __forceinline__ void pv_d0(f32x16* o, int vb, bf16x8 pa0, bf16x8 pa1, bf16x8 pa2, bf16x8 pa3) {
  pv_two<0, 1>(o[0], o[1], vb, pa0, pa1, pa2, pa3); pv_two<2, 3>(o[2], o[3], vb, pa0, pa1, pa2, pa3);
}

struct Src { const bf16* K; const bf16* V; int ld; };
template <int DQK, bool BAND>
__device__ __forceinline__ void core(const bf16* __restrict__ Qb, int ldq, const Src A, int NTA, const Src B, int NT, int q0, int kb0, lptr lds, f32x16 (&o)[4], float& m_out, float& l_out, int wv) {
  int tid = tid_of(wv); asm volatile("" : "+v"(tid));
  const int wid = tid >> 6, lane = tid & 63, r32 = lane & 31, hi = lane >> 5;
  lptr V_lds = lds; lptr K_lds = lds + 2 * SHM_V;
  LAS float* al_l = (LAS float*)(lds + 2 * SHM_V + 2 * SHM_K) + wid * 64 + 32;
  float m_reg = -1e30f, l_reg = 0.f;
#pragma unroll
  for (int d = 0; d < 4; ++d) o[d] = f32x16{};
  bf16x8 qr[DQK / 16];
  { const bf16* Qw = Qb + (size_t)(wid * 32 + r32) * ldq + hi * 8;
#pragma unroll
    for (int d0 = 0; d0 < DQK / 16; ++d0) qr[d0] = *(const bf16x8*)(Qw + d0 * 16); }
  const int qpos = q0 + wid * 32 + r32, qmin = q0 + wid * 32;
  const int sr = tid >> 4, sc = (tid & 15) * 8, vst0 = v_st(sr, sc), vst1 = v_st(32 + sr, sc);
  const int k64r = tid >> 3, k64c = (tid & 7) * 8;
  const int vb0 = (int)(uintptr_t)V_lds + v_rd_base(lane);
  struct { bf16x8 vs0, vs1, ks0, ks1; } st[2];
#define FA_SLOAD(i, t) do { const bool inA_ = (t) < NTA; const bf16* Kp_ = inA_ ? A.K : B.K; const bf16* Vp_ = inA_ ? A.V : B.V; const int ld_ = inA_ ? A.ld : B.ld; const int k0_ = (inA_ ? (t) : (t) - NTA) * KVBLK; \
    st[i].vs0 = *(const bf16x8*)(Vp_ + (size_t)(k0_ + sr) * ld_ + sc); st[i].vs1 = *(const bf16x8*)(Vp_ + (size_t)(k0_ + 32 + sr) * ld_ + sc); \
    if constexpr (DQK == 128) { st[i].ks0 = *(const bf16x8*)(Kp_ + (size_t)(k0_ + sr) * ld_ + sc); st[i].ks1 = *(const bf16x8*)(Kp_ + (size_t)(k0_ + 32 + sr) * ld_ + sc); } \
    else { st[i].ks0 = *(const bf16x8*)(Kp_ + (size_t)(k0_ + k64r) * ld_ + k64c); } } while (0)
#define FA_SWRITE(b, i) do { *(LAS bf16x8*)(V_lds + (b) * SHM_V + vst0) = st[i].vs0; *(LAS bf16x8*)(V_lds + (b) * SHM_V + vst1) = st[i].vs1; \
    if constexpr (DQK == 128) { const int kc = sc * 2; *(LAS bf16x8*)(K_lds + (b) * SHM_K + FA_KSWZ(sr, kc)) = st[i].ks0; *(LAS bf16x8*)(K_lds + (b) * SHM_K + FA_KSWZ(32 + sr, kc)) = st[i].ks1; } \
    else { *(LAS bf16x8*)(K_lds + (b) * SHM_K + FA_KSWZ64(k64r, k64c * 2)) = st[i].ks0; } } while (0)
#define FA_SWAIT() do { if constexpr (DQK == 128) asm volatile("s_waitcnt vmcnt(4)" ::: "memory"); else asm volatile("s_waitcnt vmcnt(3)" ::: "memory"); } while (0)
#define FA_RESC(a) do { if (__any((a) < 1.f)) { if (hi == 0) al_l[r32] = (a); asm volatile("s_waitcnt lgkmcnt(0)" ::: "memory"); \
    _Pragma("unroll") for (int d = 0; d < 4; ++d) _Pragma("unroll") for (int r = 0; r < 16; ++r) o[d][r] *= al_l[crow(r, hi)]; } } while (0)
#define FA_MASK(P0, P1, t) do { if constexpr (BAND) { if ((t) >= NTA) { const int kp0_ = kb0 + ((t) - NTA) * KVBLK; \
    if (!(kp0_ >= qmin + 31 - 128 && kp0_ + 63 <= qmin + 128)) band_mask(P0, P1, kp0_, qpos, hi); } } } while (0)
  f32x16 pA0, pA1, pB0, pB1; float mnA, mnB, alA, alB; bf16x8 pa0, pa1, pa2, pa3;
  FA_SLOAD(0, 0); FA_SLOAD(1, 1);
  FA_SWAIT(); FA_SWRITE(0, 0); __syncthreads();
  if (2 < NT) FA_SLOAD(0, 2);
  qkt<DQK>(pA0, pA1, K_lds, qr, r32, hi); FA_MASK(pA0, pA1, 0); partialSM<DQK>(pA0, pA1, m_reg, mnA, alA);
  FA_SWAIT(); FA_SWRITE(1, 1); __syncthreads();
  for (int j = 1; j + 1 < NT; j += 2) {
    FA_SBAR(); qkt<DQK>(pB0, pB1, K_lds + SHM_K, qr, r32, hi);
    finishSM(pA0, pA1, alA, l_reg, pa0, pa1, pa2, pa3); FA_SBAR();
    FA_SLOAD(1, j + 2); FA_SBAR();
    pv_d0(o, vb0, pa0, pa1, pa2, pa3); FA_MASK(pB0, pB1, j); partialSM<DQK>(pB0, pB1, m_reg, mnB, alB);
    __syncthreads(); FA_SWAIT(); FA_SWRITE(0, 0);
    FA_RESC(alB); __syncthreads();
    FA_SBAR(); qkt<DQK>(pA0, pA1, K_lds, qr, r32, hi);
    finishSM(pB0, pB1, alB, l_reg, pa0, pa1, pa2, pa3); FA_SBAR();
    if (j + 3 < NT) FA_SLOAD(0, j + 3); FA_SBAR();
    pv_d0(o, vb0 + SHM_V, pa0, pa1, pa2, pa3); FA_MASK(pA0, pA1, j + 1); partialSM<DQK>(pA0, pA1, m_reg, mnA, alA);
    __syncthreads(); FA_SWAIT(); FA_SWRITE(1, 1);
    FA_RESC(alA); __syncthreads();
  }
  FA_SBAR(); qkt<DQK>(pB0, pB1, K_lds + SHM_K, qr, r32, hi);
  finishSM(pA0, pA1, alA, l_reg, pa0, pa1, pa2, pa3); FA_SBAR();
  pv_d0(o, vb0, pa0, pa1, pa2, pa3); FA_MASK(pB0, pB1, NT - 1); partialSM<DQK>(pB0, pB1, m_reg, mnB, alB);
  __syncthreads(); FA_RESC(alB);
  finishSM(pB0, pB1, alB, l_reg, pa0, pa1, pa2, pa3); FA_SBAR();
  pv_d0(o, vb0 + SHM_V, pa0, pa1, pa2, pa3);
  m_out = m_reg; l_out = l_reg;
#undef FA_SLOAD
#undef FA_SWRITE
#undef FA_SWAIT
#undef FA_RESC
#undef FA_MASK
}
constexpr int CTX_SCR = 131072 + 1024;
template <int DQK, bool BAND>
__device__ __forceinline__ void core3(const bf16* __restrict__ Qb, int ldq, const Src A, int NTA, const Src B, int NT, int q0, int kb0, lptr lds, f32x16 (&o)[4], float& m_out, float& l_out, int wv) {
  int tid = tid_of(wv); asm volatile("" : "+v"(tid));
  const int wid = tid >> 6, lane = tid & 63, r32 = lane & 31, hi = lane >> 5;
  lptr V_lds = lds; lptr K_lds = lds + 3 * SHM_V;
  LAS float* al_l = (LAS float*)(lds + CTX_SCR) + wid * 64 + 32;
  float m_reg = -1e30f, l_reg = 0.f;
#pragma unroll
  for (int d = 0; d < 4; ++d) o[d] = f32x16{};
  bf16x8 qr[DQK / 16];
  { const bf16* Qw = Qb + (size_t)(wid * 32 + r32) * ldq + hi * 8;
#pragma unroll
    for (int d0 = 0; d0 < DQK / 16; ++d0) qr[d0] = *(const bf16x8*)(Qw + d0 * 16); }
  const int qpos = q0 + wid * 32 + r32, qmin = q0 + wid * 32;
  const int sr = tid >> 4, sc = (tid & 15) * 8, vst0 = v_st(sr, sc), vst1 = v_st(32 + sr, sc);
  const int k64r = tid >> 3, k64c = (tid & 7) * 8;
  const int vb0 = (int)(uintptr_t)V_lds + v_rd_base(lane);
  struct { bf16x8 vs0, vs1, ks0, ks1; } st[2];
#define C3_SLOAD(i, t) do { const bool inA_ = (t) < NTA; const bf16* Kp_ = inA_ ? A.K : B.K; const bf16* Vp_ = inA_ ? A.V : B.V; const int ld_ = inA_ ? A.ld : B.ld; const int k0_ = (inA_ ? (t) : (t) - NTA) * KVBLK; \
    st[i].vs0 = *(const bf16x8*)(Vp_ + (size_t)(k0_ + sr) * ld_ + sc); st[i].vs1 = *(const bf16x8*)(Vp_ + (size_t)(k0_ + 32 + sr) * ld_ + sc); \
    if constexpr (DQK == 128) { st[i].ks0 = *(const bf16x8*)(Kp_ + (size_t)(k0_ + sr) * ld_ + sc); st[i].ks1 = *(const bf16x8*)(Kp_ + (size_t)(k0_ + 32 + sr) * ld_ + sc); } \
    else { st[i].ks0 = *(const bf16x8*)(Kp_ + (size_t)(k0_ + k64r) * ld_ + k64c); } } while (0)
#define C3_SWRITE(b, i) do { *(LAS bf16x8*)(V_lds + (b) * SHM_V + vst0) = st[i].vs0; *(LAS bf16x8*)(V_lds + (b) * SHM_V + vst1) = st[i].vs1; \
    if constexpr (DQK == 128) { const int kc = sc * 2; *(LAS bf16x8*)(K_lds + (b) * SHM_K + FA_KSWZ(sr, kc)) = st[i].ks0; *(LAS bf16x8*)(K_lds + (b) * SHM_K + FA_KSWZ(32 + sr, kc)) = st[i].ks1; } \
    else { *(LAS bf16x8*)(K_lds + (b) * SHM_K + FA_KSWZ64(k64r, k64c * 2)) = st[i].ks0; } } while (0)
#define C3_SWAIT() do { if constexpr (DQK == 128) asm volatile("s_waitcnt vmcnt(4)" ::: "memory"); else asm volatile("s_waitcnt vmcnt(3)" ::: "memory"); } while (0)
#define C3_RESC(a) do { if (__any((a) < 1.f)) { if (hi == 0) al_l[r32] = (a); asm volatile("s_waitcnt lgkmcnt(0)" ::: "memory"); \
    _Pragma("unroll") for (int d = 0; d < 4; ++d) _Pragma("unroll") for (int r = 0; r < 16; ++r) o[d][r] *= al_l[crow(r, hi)]; } } while (0)
#define C3_MASK(P0, P1, t) do { if constexpr (BAND) { if ((t) >= NTA) { const int kp0_ = kb0 + ((t) - NTA) * KVBLK; \
    if (!(kp0_ >= qmin + 31 - 128 && kp0_ + 63 <= qmin + 128)) band_mask(P0, P1, kp0_, qpos, hi); } } } while (0)
#define C3_ITER(t, PX0, PX1, mnX, alX, PY0, PY1, alY) do { \
    FA_SBAR(); qkt<DQK>(PX0, PX1, K_lds + bt * SHM_K, qr, r32, hi); finishSM(PY0, PY1, alY, l_reg, pa0, pa1, pa2, pa3); FA_SBAR(); \
    if ((t) + 2 < NT) { if ((t) & 1) C3_SLOAD(1, (t) + 2); else C3_SLOAD(0, (t) + 2); } FA_SBAR(); \
    pv_d0(o, vb0 + bp * SHM_V, pa0, pa1, pa2, pa3); C3_MASK(PX0, PX1, (t)); partialSM<DQK>(PX0, PX1, m_reg, mnX, alX); \
    if ((t) + 1 < NT) { C3_SWAIT(); if ((t) & 1) C3_SWRITE(bn, 0); else C3_SWRITE(bn, 1); } \
    C3_RESC(alX); \
    bp = bt; bt = bn; bn = bn == 2 ? 0 : bn + 1; } while (0)
  f32x16 pA0, pA1, pB0, pB1; float mnA, mnB, alA, alB; bf16x8 pa0, pa1, pa2, pa3;
  C3_SLOAD(0, 0); C3_SLOAD(1, 1);
  C3_SWAIT(); C3_SWRITE(0, 0); __syncthreads();
  if (2 < NT) C3_SLOAD(0, 2);
  qkt<DQK>(pA0, pA1, K_lds, qr, r32, hi); C3_MASK(pA0, pA1, 0); partialSM<DQK>(pA0, pA1, m_reg, mnA, alA);
  C3_SWAIT(); C3_SWRITE(1, 1); __syncthreads();
  int bt = 1, bp = 0, bn = 2;
  for (int t = 1; t + 2 < NT; t += 2) {
    C3_ITER(t, pB0, pB1, mnB, alB, pA0, pA1, alA); __syncthreads();
    C3_ITER(t + 1, pA0, pA1, mnA, alA, pB0, pB1, alB); __syncthreads();
  }
  C3_ITER(NT - 1, pB0, pB1, mnB, alB, pA0, pA1, alA);
  finishSM(pB0, pB1, alB, l_reg, pa0, pa1, pa2, pa3); FA_SBAR();
  pv_d0(o, vb0 + bp * SHM_V, pa0, pa1, pa2, pa3);
  m_out = m_reg; l_out = l_reg;
#undef C3_SLOAD
#undef C3_SWRITE
#undef C3_SWAIT
#undef C3_RESC
#undef C3_MASK
#undef C3_ITER
}
template <int DQK>
__device__ __forceinline__ void core_ctx(const bf16* __restrict__ Qb, int ldq, const Src A, lptr lds, f32x16 (&o)[4], float& m_out, float& l_out, int wv) {
  int tid = tid_of(wv); asm volatile("" : "+v"(tid));
  const int wid = tid >> 6, lane = tid & 63, r32 = lane & 31, hi = lane >> 5;
  lptr V_lds = lds; lptr K_lds = lds + 4 * SHM_V;
  LAS float* al_l = (LAS float*)(lds + CTX_SCR) + wid * 64 + 32;
  float m_reg = -1e30f, l_reg = 0.f;
  bf16x8 qr[DQK / 16];
  { const bf16* Qw = Qb + (size_t)(wid * 32 + r32) * ldq + hi * 8;
#pragma unroll
    for (int d0 = 0; d0 < DQK / 16; ++d0) qr[d0] = *(const bf16x8*)(Qw + d0 * 16); }
  { const int sr = tid >> 4, sc = (tid & 15) * 8, vst0 = v_st(sr, sc), vst1 = v_st(32 + sr, sc); const int k64r = tid >> 3, k64c = (tid & 7) * 8;
    bf16x8 vs[4][2], ks[4][2];
#pragma unroll
    for (int t = 0; t < 4; ++t) { vs[t][0] = *(const bf16x8*)(A.V + (size_t)(t * 64 + sr) * A.ld + sc); vs[t][1] = *(const bf16x8*)(A.V + (size_t)(t * 64 + 32 + sr) * A.ld + sc);
      if constexpr (DQK == 128) { ks[t][0] = *(const bf16x8*)(A.K + (size_t)(t * 64 + sr) * A.ld + sc); ks[t][1] = *(const bf16x8*)(A.K + (size_t)(t * 64 + 32 + sr) * A.ld + sc); }
      else ks[t][0] = *(const bf16x8*)(A.K + (size_t)(t * 64 + k64r) * A.ld + k64c); }
#pragma unroll
    for (int t = 0; t < 4; ++t) { *(LAS bf16x8*)(V_lds + t * SHM_V + vst0) = vs[t][0]; *(LAS bf16x8*)(V_lds + t * SHM_V + vst1) = vs[t][1];
      if constexpr (DQK == 128) { *(LAS bf16x8*)(K_lds + t * SHM_K + FA_KSWZ(sr, sc * 2)) = ks[t][0]; *(LAS bf16x8*)(K_lds + t * SHM_K + FA_KSWZ(32 + sr, sc * 2)) = ks[t][1]; }
      else *(LAS bf16x8*)(K_lds + t * SHM_K + FA_KSWZ64(k64r, k64c * 2)) = ks[t][0]; } }
  __syncthreads();
#pragma unroll
  for (int d = 0; d < 4; ++d) o[d] = f32x16{};
  const int vb0 = (int)(uintptr_t)V_lds + v_rd_base(lane);
#define FA_RESC(a) do { if (__any((a) < 1.f)) { if (hi == 0) al_l[r32] = (a); asm volatile("s_waitcnt lgkmcnt(0)" ::: "memory"); \
    _Pragma("unroll") for (int d = 0; d < 4; ++d) _Pragma("unroll") for (int r = 0; r < 16; ++r) o[d][r] *= al_l[crow(r, hi)]; } } while (0)
  f32x16 pA0, pA1, pB0, pB1; float mnA, mnB, alA, alB; bf16x8 pa0, pa1, pa2, pa3;
  qkt<DQK>(pA0, pA1, K_lds, qr, r32, hi); partialSM<DQK>(pA0, pA1, m_reg, mnA, alA);
  FA_SBAR(); qkt<DQK>(pB0, pB1, K_lds + SHM_K, qr, r32, hi); finishSM(pA0, pA1, alA, l_reg, pa0, pa1, pa2, pa3); FA_SBAR();
  pv_d0(o, vb0, pa0, pa1, pa2, pa3); partialSM<DQK>(pB0, pB1, m_reg, mnB, alB); FA_RESC(alB);
  FA_SBAR(); qkt<DQK>(pA0, pA1, K_lds + 2 * SHM_K, qr, r32, hi); finishSM(pB0, pB1, alB, l_reg, pa0, pa1, pa2, pa3); FA_SBAR();
  pv_d0(o, vb0 + SHM_V, pa0, pa1, pa2, pa3); partialSM<DQK>(pA0, pA1, m_reg, mnA, alA); FA_RESC(alA);
  FA_SBAR(); qkt<DQK>(pB0, pB1, K_lds + 3 * SHM_K, qr, r32, hi); finishSM(pA0, pA1, alA, l_reg, pa0, pa1, pa2, pa3); FA_SBAR();
  pv_d0(o, vb0 + 2 * SHM_V, pa0, pa1, pa2, pa3); partialSM<DQK>(pB0, pB1, m_reg, mnB, alB); FA_RESC(alB);
  finishSM(pB0, pB1, alB, l_reg, pa0, pa1, pa2, pa3); FA_SBAR();
  pv_d0(o, vb0 + 3 * SHM_V, pa0, pa1, pa2, pa3);
  m_out = m_reg; l_out = l_reg;
#undef FA_RESC
}
__device__ __forceinline__ void row_bcast(float lv, lptr scratch, int wid, int r32, int hi, float (&f)[16]) {
  LAS float* li_l = (LAS float*)scratch + wid * 64;
  if (hi == 0) li_l[r32] = lv; asm volatile("s_waitcnt lgkmcnt(0)" ::: "memory");
#pragma unroll
  for (int r = 0; r < 16; ++r) f[r] = li_l[crow(r, hi)];
  asm volatile("s_waitcnt lgkmcnt(0)" ::: "memory");
}
constexpr int TILE_STRIDE = 272, TILE_BYTES = 32 * TILE_STRIDE;
__device__ __forceinline__ void tile_put(lptr tile, int r32, int hi, const f32x16 (&o)[4], const float (&sc)[16]) {
#pragma unroll
  for (int rr = 0; rr < 16; ++rr) { const int row = crow(rr, hi);
#pragma unroll
    for (int d0 = 0; d0 < 4; d0 += 2) { const unsigned w = pk2(o[d0][rr] * sc[rr], o[d0 + 1][rr] * sc[rr]);
      *(LAS bf16*)(tile + row * TILE_STRIDE + (d0 * 32 + r32) * 2) = (bf16)(w & 0xffffu); *(LAS bf16*)(tile + row * TILE_STRIDE + ((d0 + 1) * 32 + r32) * 2) = (bf16)(w >> 16); } }
}
__device__ __forceinline__ void tile_gates(int lane, const bf16* gate_rows, v4u (&gq)[8]) {
#pragma unroll
  for (int it = 0; it < 8; ++it) { const int c = it * 64 + lane, row = c >> 4, cc = (c & 15) * 8; gq[it] = *(const v4u*)(gate_rows + (size_t)row * DIN + cc); }
}
__device__ __forceinline__ void tile_emit(lptr tile, int lane, const v4u (&gq)[8], bf16* mix_rows, const float* colscale) {
#pragma unroll
  for (int it = 0; it < 8; ++it) { const int c = it * 64 + lane, row = c >> 4, cc = (c & 15) * 8;
    const v4u tv = *(const LAS v4u*)(tile + row * TILE_STRIDE + cc * 2); const v4u gv = gq[it];
    float x[8] = {blo(tv.x), bhi(tv.x), blo(tv.y), bhi(tv.y), blo(tv.z), bhi(tv.z), blo(tv.w), bhi(tv.w)};
    const float g[8] = {blo(gv.x), bhi(gv.x), blo(gv.y), bhi(gv.y), blo(gv.z), bhi(gv.z), blo(gv.w), bhi(gv.w)};
    if (colscale) { const f32x4 s0 = *(const f32x4*)(colscale + cc), s1 = *(const f32x4*)(colscale + cc + 4); x[0] *= s0.x; x[1] *= s0.y; x[2] *= s0.z; x[3] *= s0.w; x[4] *= s1.x; x[5] *= s1.y; x[6] *= s1.z; x[7] *= s1.w; }
#pragma unroll
    for (int t = 0; t < 8; ++t) x[t] *= siluf(g[t]);
    v4u w; w.x = pk2(x[0], x[1]); w.y = pk2(x[2], x[3]); w.z = pk2(x[4], x[5]); w.w = pk2(x[6], x[7]);
    *(v4u*)(mix_rows + (size_t)row * DM + cc) = w; }
}
}

template <int BR, bool LAT>
__device__ __forceinline__ void attn_fast_unit(CArgs& a, int l, int r, LAS unsigned char* lds_u, int wv) {
  fa::lptr lds = (fa::lptr)lds_u;
  const int b = LAT ? r >> 7 : r >> 3, h = LAT ? (r >> 4) & 7 : r & 7, qb = LAT ? r & 15 : 0, kv = h >> 2;
  const int rowbase = LAT ? MC + b * LSEQ : b * SEQ, q0 = qb * 256;
  const bf16* proj = (const bf16*)(a.ws + WS_PROJ); const bf16* pk = proj + (size_t)rowbase * DIN; const bf16* pq = pk + (size_t)q0 * DIN;
  fa::f32x16 o[4]; float mreg, lreg; float f[16];
  constexpr int NTL = LAT ? LSEQ / 64 : SEQ / 64, NTC = LAT ? 4 : 0;
#define FA_IDS() int tid_ = tid_of(wv); asm volatile("" : "+v"(tid_)); const int wid = tid_ >> 6, lane = tid_ & 63, r32 = lane & 31, hi = lane >> 5; (void)lane; \
  bf16* mix = (bf16*)(a.ws + WS_HM) + (size_t)(rowbase + q0 + wid * 32) * DM; const bf16* gate = pq + (size_t)(wid * 32) * DIN; (void)mix; (void)gate
  if constexpr (BR == 1) {
    const fa::Src S1{pk + B_K + kv * 128, pk + B_V + kv * 128, DIN};
    const fa::Src S2{(const bf16*)(a.ws + WS_CBK) + (size_t)(b * 2 + l) * 65536 + kv * 128, (const bf16*)(a.ws + WS_CBV) + (size_t)(b * 2 + l) * 65536 + kv * 128, 256};
    if constexpr (LAT) fa::core3<128, false>(pq + B_Q + h * 128, DIN, S1, NTL, S2, NTL + NTC, 0, 0, lds, o, mreg, lreg, wv); else fa::core_ctx<128>(pq + B_Q + h * 128, DIN, S1, lds, o, mreg, lreg, wv);
    FA_IDS();
    v4u gq[8]; fa::tile_gates(lane, gate + B_G + h * 128, gq);
    __syncthreads();
    fa::row_bcast(lreg, lds + fa::CTX_SCR, wid, r32, hi, f);
#pragma unroll
    for (int rr = 0; rr < 16; ++rr) f[rr] = __builtin_amdgcn_rcpf(f[rr]);
    fa::tile_put(lds + wid * fa::TILE_BYTES, r32, hi, o, f); __builtin_amdgcn_wave_barrier();
    fa::tile_emit(lds + wid * fa::TILE_BYTES, lane, gq, mix + 1024 + h * 128, nullptr);
  } else if constexpr (BR == 2) {
    const fa::Src SL{pk + D_K + kv * 128, pk + D_V + kv * 128, DIN};
    const fa::Src SC{(const bf16*)(a.ws + WS_CDK) + (size_t)(b * 2 + l) * 65536 + kv * 128, (const bf16*)(a.ws + WS_CDV) + (size_t)(b * 2 + l) * 65536 + kv * 128, 256};
    if constexpr (LAT) {
      const int kb = q0 - 128 < 0 ? 0 : q0 - 128, ke = q0 + 384 > LSEQ ? LSEQ : q0 + 384;
      const fa::Src SLb{SL.K + (size_t)kb * DIN, SL.V + (size_t)kb * DIN, DIN};
      fa::core3<128, true>(pq + D_Q + h * 128, DIN, SC, 4, SLb, 4 + (ke - kb) / 64, q0, kb, lds, o, mreg, lreg, wv);
    } else fa::core_ctx<128>(pq + D_Q + h * 128, DIN, SL, lds, o, mreg, lreg, wv);
    { const float sink = a.in[I_SINK][l * 8 + h]; lreg += __builtin_amdgcn_exp2f(sink * 1.4426950408889634f - mreg * (0.088388347648318440f * 1.4426950408889634f)); }
    FA_IDS();
    v4u gq[8]; fa::tile_gates(lane, gate + D_G + h * 128, gq);
    __syncthreads();
    fa::row_bcast(lreg, lds + fa::CTX_SCR, wid, r32, hi, f);
#pragma unroll
    for (int rr = 0; rr < 16; ++rr) f[rr] = __builtin_amdgcn_rcpf(f[rr]);
    fa::tile_put(lds + wid * fa::TILE_BYTES, r32, hi, o, f); __builtin_amdgcn_wave_barrier();
    fa::tile_emit(lds + wid * fa::TILE_BYTES, lane, gq, mix + 3072 + h * 128, nullptr);
  } else {
    const bf16* ck = (const bf16*)(a.ws + WS_CAK) + (size_t)(b * 2 + l) * 262144 + h * 128; const bf16* cv = (const bf16*)(a.ws + WS_CAV) + (size_t)(b * 2 + l) * 262144 + h * 128;
    { const fa::Src S1{pk + A_K + h * 128, pk + A_V + h * 128, DIN}; const fa::Src S2{ck, cv, 1024};
      if constexpr (LAT) fa::core3<64, false>(pq + A_Q + h * 128, DIN, S1, NTL, S2, NTL + NTC, 0, 0, lds, o, mreg, lreg, wv); else { fa::core_ctx<64>(pq + A_Q + h * 128, DIN, S1, lds, o, mreg, lreg, wv); } }
    { FA_IDS();
      fa::row_bcast(lreg, lds + fa::CTX_SCR, wid, r32, hi, f);
      float* scr = (float*)(a.ws + WS_ASCR) + ((size_t)blockIdx.x * 8 + wid) * 4096 + lane;
#pragma unroll
      for (int rr = 0; rr < 16; ++rr) { const float il = __builtin_amdgcn_rcpf(f[rr]);
#pragma unroll
        for (int d0 = 0; d0 < 4; ++d0) scr[(d0 * 16 + rr) * 64] = o[d0][rr] * il; } }
    { const fa::Src S1{pk + A_K + h * 128 + 64, pk + A_V + h * 128, DIN}; const fa::Src S2{ck + 64, cv, 1024};
      if constexpr (LAT) { __syncthreads(); fa::core3<64, false>(pq + A_Q + h * 128 + 64, DIN, S1, NTL, S2, NTL + NTC, 0, 0, lds, o, mreg, lreg, wv); } else { __syncthreads(); fa::core_ctx<64>(pq + A_Q + h * 128 + 64, DIN, S1, lds, o, mreg, lreg, wv); } }
    FA_IDS();
    fa::row_bcast(lreg, lds + fa::CTX_SCR, wid, r32, hi, f);
    const float* scr = (const float*)(a.ws + WS_ASCR) + ((size_t)blockIdx.x * 8 + wid) * 4096 + lane;
    const float lam = ((const float*)(a.ws + WS_LAM))[l], lam_init = l == 0 ? 0.2f : 0.35550906759f;
#pragma unroll
    for (int rr = 0; rr < 16; ++rr) { const float il = lam * __builtin_amdgcn_rcpf(f[rr]); float s = 0.f;
#pragma unroll
      for (int d0 = 0; d0 < 4; ++d0) { const float w = scr[(d0 * 16 + rr) * 64] - o[d0][rr] * il; o[d0][rr] = w; s += w * w; }
      s = red32(s);
      f[rr] = (1.f - lam_init) / sqrtf(s * (1.f / 128.f) + RMS_EPS); }
    __syncthreads();
    v4u gq[8]; fa::tile_gates(lane, gate + A_G + h * 128, gq);
    fa::tile_put(lds + wid * fa::TILE_BYTES, r32, hi, o, f); __builtin_amdgcn_wave_barrier();
    fa::tile_emit(lds + wid * fa::TILE_BYTES, lane, gq, mix + h * 128, a.in[I_SUBG] + l * 128);
  }
#undef FA_IDS
  __syncthreads();
}
namespace s5 {
using bf16x8 = __attribute__((ext_vector_type(8))) short;
using f32x16 = __attribute__((ext_vector_type(16))) float;
typedef LAS char* lptr;
constexpr int H_STRIDE = 288, SEQ_LDS = 16 * H_STRIDE, WAVE_LDS = 2 * SEQ_LDS, SEG_OFF = 8 * WAVE_LDS;
struct Par { bf16x8 bbh[4], bbl[4], cm[4]; float ar0, ai0, ar1, ai1; };
__device__ __forceinline__ void load_par(CArgs& a, int l, int d, int g, int lane, Par& P) {
    const int col = lane & 31, h = lane >> 5, c15 = lane & 15, kg = lane >> 4;
    const float* sa = (const float*)(a.ws + WS_S5A); const float* sbb = (const float*)(a.ws + WS_S5BB);
    const int base = (l * 2 + d) * 64 + g;
    { const float* pa = sa + base * 64 + 2 * col; P.ar0 = pa[0]; P.ar1 = pa[1]; P.ai0 = pa[16384]; P.ai1 = pa[16384 + 1]; }
#pragma unroll
    for (int blk = 0; blk < 4; ++blk) { const int part = blk >> 1, p = 2 * col + (blk & 1);
        const float* src = sbb + (size_t)part * 262144 + ((size_t)(base * 64 + p)) * 16 + 8 * h;
        const f32x4 x0 = *(const f32x4*)src, x1 = *(const f32x4*)(src + 4); const float x[8] = {x0.x, x0.y, x0.z, x0.w, x1.x, x1.y, x1.z, x1.w}; float lo[8];
#pragma unroll
        for (int j = 0; j < 8; ++j) lo[j] = x[j] - __uint_as_float(f2bf(x[j]) << 16);
        const v4u wh = {pk2(x[0], x[1]), pk2(x[2], x[3]), pk2(x[4], x[5]), pk2(x[6], x[7])}, wl = {pk2(lo[0], lo[1]), pk2(lo[2], lo[3]), pk2(lo[4], lo[5]), pk2(lo[6], lo[7])};
        P.bbh[blk] = __builtin_bit_cast(bf16x8, wh); P.bbl[blk] = __builtin_bit_cast(bf16x8, wl); }
#pragma unroll
    for (int ks = 0; ks < 4; ++ks) { const int part = ks >> 1, p0 = 32 * (ks & 1) + 8 * kg;
        const float* src = (part ? a.in[I_CCIM] : a.in[I_CCRE]) + ((size_t)(base * 16 + c15)) * 64 + p0;
        const f32x4 x0 = *(const f32x4*)src, x1 = *(const f32x4*)(src + 4); const float sg = part ? -1.f : 1.f;
        const v4u w = {pk2(sg * x0.x, sg * x0.y), pk2(sg * x0.z, sg * x0.w), pk2(sg * x1.x, sg * x1.y), pk2(sg * x1.z, sg * x1.w)}; P.cm[ks] = __builtin_bit_cast(bf16x8, w); }
}
template <bool FULL, int DIR>
__device__ __forceinline__ void run(const bf16* u0, const bf16* u1, int t_lo, int t_hi, const Par& P, float& hr0, float& hi0, float& hr1, float& hi1, lptr ldsw, float* yf, bf16* yact, size_t ystep, float dc, int lane) {
    const int col = lane & 31, sq = lane >> 5, c15 = lane & 15, kg = lane >> 4;
    lptr Hs = ldsw + sq * SEQ_LDS;
    const int nch = (t_hi - t_lo) >> 4;
    const bf16* up = (((col >> 2) & 1) ? u1 : u0) + (size_t)((col & 3) + 4 * (col >> 3)) * DIN + 8 * sq;
#define S5_BPROJ(U) do { _Pragma("unroll") for (int blk_ = 0; blk_ < 4; ++blk_) { acc[blk_] = __builtin_amdgcn_mfma_f32_32x32x16_bf16(U, P.bbh[blk_], f32x16{}, 0, 0, 0); } } while (0)
#define S5_T0(ci_) (DIR == 0 ? t_lo + 16 * (ci_) : t_hi - 16 - 16 * (ci_))
#define S5_ULOAD(ci_) (*(const bf16x8*)(up + (size_t)S5_T0(ci_) * DIN))
    f32x16 acc[4]; bf16x8 unext;
    { const bf16x8 u_first = S5_ULOAD(0); unext = nch > 1 ? S5_ULOAD(1) : u_first; S5_BPROJ(u_first); }
    float yn[2][4]; bf16 un[2][4];
#define S5_PREF(T0) do { _Pragma("unroll") for (int s2_ = 0; s2_ < 2; ++s2_) _Pragma("unroll") for (int i_ = 0; i_ < 4; ++i_) { const int tok_ = (T0) + 4 * kg + i_; \
        yn[s2_][i_] = yf[((size_t)tok_ + ystep * s2_) * 1024 + c15]; un[s2_][i_] = (s2_ ? u1 : u0)[(size_t)tok_ * DIN + c15]; } } while (0)
    if constexpr (FULL && DIR == 1) S5_PREF(S5_T0(0));
    for (int ci = 0; ci < nch; ++ci) {
        const int t0 = S5_T0(ci);
        float yc[2][4]; bf16 uc[2][4];
        if constexpr (FULL && DIR == 1) {
#pragma unroll
            for (int s2 = 0; s2 < 2; ++s2)
#pragma unroll
                for (int i = 0; i < 4; ++i) { yc[s2][i] = yn[s2][i]; uc[s2][i] = un[s2][i]; }
            if (ci + 1 < nch) S5_PREF(S5_T0(ci + 1));
        }
#pragma unroll
        for (int s = 0; s < 16; ++s) { const int r = DIR == 0 ? s : 15 - s;
            const float n0r = P.ar0 * hr0 - P.ai0 * hi0 + acc[0][r], n0i = P.ar0 * hi0 + P.ai0 * hr0 + acc[2][r]; hr0 = n0r; hi0 = n0i;
            const float n1r = P.ar1 * hr1 - P.ai1 * hi1 + acc[1][r], n1i = P.ar1 * hi1 + P.ai1 * hr1 + acc[3][r]; hr1 = n1r; hi1 = n1i;
            if constexpr (FULL) { *(LAS unsigned*)(Hs + r * H_STRIDE + col * 4) = pk2(hr0, hr1); *(LAS unsigned*)(Hs + r * H_STRIDE + 128 + col * 4) = pk2(hi0, hi1); } }
        if (ci + 1 < nch) { const bf16x8 ucur = unext; if (ci + 2 < nch) unext = S5_ULOAD(ci + 2); S5_BPROJ(ucur); }
        if constexpr (FULL) {
            __builtin_amdgcn_wave_barrier();
#pragma unroll
            for (int s2 = 0; s2 < 2; ++s2) {
                f32x4 y = {0.f, 0.f, 0.f, 0.f};
#pragma unroll
                for (int ks = 0; ks < 4; ++ks) { const bf16x8 af = *(const LAS bf16x8*)(ldsw + s2 * SEQ_LDS + c15 * H_STRIDE + (32 * ks + 8 * kg) * 2); y = __builtin_amdgcn_mfma_f32_16x16x32_bf16(af, P.cm[ks], y, 0, 0, 0); }
#pragma unroll
                for (int i = 0; i < 4; ++i) { const int tok = t0 + 4 * kg + i; const size_t yo = ((size_t)tok + ystep * s2) * 1024 + c15;
                    if constexpr (DIR == 0) yf[yo] = y[i];
                    else { const float v = yc[s2][i] + y[i] + bf2f(uc[s2][i]) * dc; yact[yo] = (bf16)f2bf(gelu_tanh(v)); } }
            }
            __builtin_amdgcn_wave_barrier();
        }
    }
#undef S5_PREF
#undef S5_BPROJ
#undef S5_T0
#undef S5_ULOAD
}
__device__ __forceinline__ void ctx_unit(CArgs& a, int l, int cu, lptr ldsw, int lane) {
    const int bp = cu & 15, g = cu >> 4; const int rowbase = bp * SEQ; const int col = lane & 31, sq = lane >> 5, b = bp + 16 * sq;
    const bf16* u0 = (const bf16*)(a.ws + WS_PROJ) + (size_t)rowbase * DIN + C_U + g * 16; const bf16* u1 = u0 + (size_t)16 * SEQ * DIN;
    float* yf = (float*)(a.ws + WS_YD) + (size_t)rowbase * 1024 + g * 16; bf16* yact = (bf16*)(a.ws + WS_YACT) + (size_t)rowbase * 1024 + g * 16;
    const float dc = a.in[I_CD][l * 1024 + g * 16 + (lane & 15)];
    Par P;
    { load_par(a, l, 0, g, lane, P); float h0r = 0.f, h0i = 0.f, h1r = 0.f, h1i = 0.f; run<true, 0>(u0, u1, 0, SEQ, P, h0r, h0i, h1r, h1i, ldsw, yf, yact, (size_t)16 * SEQ, dc, lane);
      const int oi = (((b * 2 + l) * 2 + 0) * 64 + g) * 64 + 2 * col; *(v2u*)(a.out + O_CRE + oi) = (v2u){__float_as_uint(h0r), __float_as_uint(h1r)}; *(v2u*)(a.out + O_CIM + oi) = (v2u){__float_as_uint(h0i), __float_as_uint(h1i)}; }
    { load_par(a, l, 1, g, lane, P); float h0r = 0.f, h0i = 0.f, h1r = 0.f, h1i = 0.f; run<true, 1>(u0, u1, 0, SEQ, P, h0r, h0i, h1r, h1i, ldsw, yf, yact, (size_t)16 * SEQ, dc, lane);
      const int oi = (((b * 2 + l) * 2 + 1) * 64 + g) * 64 + 2 * col; *(v2u*)(a.out + O_CRE + oi) = (v2u){__float_as_uint(h0r), __float_as_uint(h1r)}; *(v2u*)(a.out + O_CIM + oi) = (v2u){__float_as_uint(h0i), __float_as_uint(h1i)}; }
}
template <int NSQ> __device__ __forceinline__ void cpow2n(float ar, float ai, float& pr, float& pi) { pr = ar; pi = ai;
#pragma unroll
    for (int i = 0; i < NSQ; ++i) { const float nr = pr * pr - pi * pi, ni = 2.f * pr * pi; pr = nr; pi = ni; } }
__device__ __forceinline__ void lat_pass1(CArgs& a, int l, int lu, lptr lds, int wave, int lane) {
    const int g = lu >> 2, seg = (lu & 3) * 8 + wave;
    const bf16* u0 = (const bf16*)(a.ws + WS_PROJ) + (size_t)MC * DIN + C_U + g * 16; const bf16* u1 = u0 + (size_t)LSEQ * DIN;
    f32x4* SEG = (f32x4*)(a.ws + WS_SEG);
    const int t_lo = seg * 128, t_hi = t_lo + 128;
    Par P;
#pragma unroll
    for (int d = 0; d < 2; ++d) { load_par(a, l, d, g, lane, P); float h0r = 0.f, h0i = 0.f, h1r = 0.f, h1i = 0.f;
        if (d == 0) run<false, 0>(u0, u1, t_lo, t_hi, P, h0r, h0i, h1r, h1i, lds, nullptr, nullptr, 0, 0.f, lane); else run<false, 1>(u0, u1, t_lo, t_hi, P, h0r, h0i, h1r, h1i, lds, nullptr, nullptr, 0, 0.f, lane);
        SEG[((size_t)(g * 2 + d) * 32 + seg) * 64 + lane] = (f32x4){h0r, h0i, h1r, h1i}; }
}
__device__ __forceinline__ void lat_pass2(CArgs& a, int l, int lu, lptr lds, int wave, int lane) {
    const int g = lu >> 2, seg = (lu & 3) * 8 + wave; const int col = lane & 31, sq = lane >> 5;
    const bf16* u0 = (const bf16*)(a.ws + WS_PROJ) + (size_t)MC * DIN + C_U + g * 16; const bf16* u1 = u0 + (size_t)LSEQ * DIN;
    float* yf = (float*)(a.ws + WS_YD) + (size_t)MC * 1024 + g * 16; bf16* yact = (bf16*)(a.ws + WS_YACT) + (size_t)MC * 1024 + g * 16;
    const float dc = a.in[I_CD][l * 1024 + g * 16 + (lane & 15)];
    const f32x4* SEG = (const f32x4*)(a.ws + WS_SEG);
    lptr ldsw = lds + wave * WAVE_LDS;
    const int t_lo = seg * 128, t_hi = t_lo + 128;
    Par P;
#pragma unroll
    for (int d = 0; d < 2; ++d) { load_par(a, l, d, g, lane, P); float p0r, p0i, p1r, p1i; cpow2n<7>(P.ar0, P.ai0, p0r, p0i); cpow2n<7>(P.ar1, P.ai1, p1r, p1i);
        const int si = (((sq * 2 + l) * 2 + d) * 64 + g) * 64 + 2 * col;
        float h0r = a.in[I_SRE][si], h0i = a.in[I_SIM][si], h1r = a.in[I_SRE][si + 1], h1i = a.in[I_SIM][si + 1];
        const int nv = d == 0 ? seg : 31 - seg;
        const f32x4* sp = SEG + ((size_t)(g * 2 + d) * 32) * 64 + lane;
        for (int k0 = 0; k0 < nv; k0 += 8) {
            f32x4 sv[8];
#pragma unroll
            for (int j = 0; j < 8; ++j) { const int k = k0 + j < nv ? k0 + j : nv - 1; const int v = d == 0 ? k : 31 - k; sv[j] = sp[(size_t)v * 64]; }
#pragma unroll
            for (int j = 0; j < 8; ++j) if (k0 + j < nv) { const f32x4 s = sv[j];
                const float n0r = p0r * h0r - p0i * h0i + s.x, n0i = p0r * h0i + p0i * h0r + s.y, n1r = p1r * h1r - p1i * h1i + s.z, n1i = p1r * h1i + p1i * h1r + s.w; h0r = n0r; h0i = n0i; h1r = n1r; h1i = n1i; }
        }
        if (d == 0) run<true, 0>(u0, u1, t_lo, t_hi, P, h0r, h0i, h1r, h1i, ldsw, yf, yact, (size_t)LSEQ, dc, lane); else run<true, 1>(u0, u1, t_lo, t_hi, P, h0r, h0i, h1r, h1i, ldsw, yf, yact, (size_t)LSEQ, dc, lane); }
}
}
__global__ void __launch_bounds__(NTHREADS, 2) fwd(Args args_by_value) {
    extern __shared__ __attribute__((aligned(16))) unsigned char lds_raw[];
    LAS unsigned char* lds = (LAS unsigned char*)lds_raw;
    volatile LAS unsigned* MISC = (volatile LAS unsigned*)(lds + MISC_OFF);
#define IDS() int tid_ = tid_of(wv); asm volatile("" : "+v"(tid_)); const int lane = tid_ & 63, wave = __builtin_amdgcn_readfirstlane(tid_ >> 6); const int G = gridDim.x, gw = blockIdx.x * NWAVES + wave, NGW = G * NWAVES; (void)lane; (void)gw; (void)NGW; (void)G; \
    CArgs* kp_ = (CArgs*)__builtin_amdgcn_kernarg_segment_ptr(); asm volatile("" : "+s"(kp_)); CArgs& args = *kp_; \
    unsigned char* ws = args.ws; const float* ada_l = (const float*)(ws + WS_ADA) + (size_t)l * 3 * 12288; bf16* HM = (bf16*)(ws + WS_HM); bf16* PROJ = (bf16*)(ws + WS_PROJ); bf16* XR = (bf16*)(ws + WS_XR); (void)ada_l; (void)HM; (void)PROJ; (void)XR
    const int wv = __builtin_amdgcn_readfirstlane((int)threadIdx.x >> 6);
    for (int u = threadIdx.x; u < (LDS_BYTES - LDSCTL_OFF) / 4; u += NTHREADS) ((LAS unsigned*)(lds + LDSCTL_OFF))[u] = 0u;
    __syncthreads();
    XcdBarrier bar;
#define GRID_BAR() do { XcdBarrier b_ = bar; asm volatile("" : "+s"(b_.x)); xcd_barrier(b_, tid_of(wv) == 0); } while (0)
    { CArgs& args0 = *(CArgs*)__builtin_amdgcn_kernarg_segment_ptr(); bar = xcd_barrier_post((unsigned*)(args0.ws + WS_CTL) + CW_BAR, MISC + 8, tid_of(wv) == 0);
      p0_ada(args0, lds, wv); }
    GRID_BAR();
    { const int l = 0; IDS(); p0_prologue(args, lds, wv);
      { LAS unsigned char* buf = lds + wave * 16384; int m = gw; if (m < M) row_dma<16>(x_row_in(args, m), buf, lane);
        for (; m < M; m += NGW) { f32x4 v[16];
          asm volatile("s_waitcnt vmcnt(0)" ::: "memory"); row_lds_f32(buf, lane, v); asm volatile("s_waitcnt lgkmcnt(0)" ::: "memory");
          if (m + NGW < M) row_dma<16>(x_row_in(args, m + NGW), buf, lane);
          ln_mod_apply(v, ada_l + (size_t)cond_of_row(m) * 12288, HM + (size_t)m * DM, lane); } } }
    GRID_BAR();

    for (int l = 0; l < DEPTH; ++l) {
        { IDS();
            pg8::Gemm g{HM, (const bf16*)(ws + WS_WIN) + (size_t)l * DIN * DM, M, DIN, DM}; pg8::StaticOrder S; S.init(M, DIN, G, (int)blockIdx.x);
            pg8::EpiBf16<0> E{PROJ, DIN, nullptr, 0, 0, 1.f};
            pg8::gemm_phase<pg8::EpiBf16<0>, pg8::StaticOrder, true, true>(lds + RING_OFF, g, S, E, wv); }
        GRID_BAR();
        { IDS();
            for (int lu = blockIdx.x; lu < 256; lu += G) s5::lat_pass1(args, l, lu, (s5::lptr)lds + wave * s5::WAVE_LDS, wave, lane);
            if (wave < 4) { for (int cu = (int)blockIdx.x * 4 + wave; cu < 1024; cu += G * 4) s5::ctx_unit(args, l, cu, (s5::lptr)lds + wave * s5::WAVE_LDS, lane); }
            else for (int m = (int)blockIdx.x * 4 + wave - 4; m < M; m += G * 4) post_row(args, l, m, lane);
            GRID_BAR();
            for (int lu = blockIdx.x; lu < 256; lu += G) s5::lat_pass2(args, l, lu, (s5::lptr)lds, wave, lane); }
        GRID_BAR();
        { IDS();
            const int xg = (int)blockIdx.x & 7, ig = (int)blockIdx.x >> 3;
            const int u_bd = G == 256 ? ((((xg >> 1) * 4 + ((xg & 1) * 2 + (ig >> 4))) * 16) + (ig & 15)) : -1;
            const int u_a = G == 256 ? (((xg * 2 + (ig >> 4)) * 16) + (ig & 15)) : -1;
            for (int u = blockIdx.x; u < 256; u += G) attn_fast_unit<1, true>(args, l, G == 256 ? u_bd : u, lds, wv);
            for (int u = blockIdx.x; u < 256; u += G) attn_fast_unit<2, true>(args, l, G == 256 ? u_bd : u, lds, wv);
            for (int u = blockIdx.x; u < 256; u += G) attn_fast_unit<1, false>(args, l, u, lds, wv);
            for (int u = blockIdx.x; u < 256; u += G) attn_fast_unit<2, false>(args, l, u, lds, wv);
            for (int u = blockIdx.x; u < 256; u += G) attn_fast_unit<0, true>(args, l, G == 256 ? u_a : u, lds, wv);
            for (int u = blockIdx.x; u < 256; u += G) attn_fast_unit<0, false>(args, l, u, lds, wv);
            pg8::Gemm g{(const bf16*)(ws + WS_YACT), (const bf16*)(ws + WS_GLU) + (size_t)l * 1024 * 1024, M, 1024, 1024}; pg8::StaticOrder S; S.init(M, 1024, G, (int)blockIdx.x);
            pg8::EpiGlu E{HM, (const bf16*)(ws + WS_YACT), PROJ, args.in[I_GLUB] + l * 1024, DM, 1024, DIN, 2048, C_G};
            pg8::gemm_phase<pg8::EpiGlu, pg8::StaticOrder, true, true>(lds + RING_OFF, g, S, E, wv); }
        GRID_BAR();
        { IDS();
            pg8::Gemm g{HM, (const bf16*)(ws + WS_WOUT) + (size_t)l * DM * DM, M, DM, DM}; pg8::StaticOrder S; S.init(M, DM, G, (int)blockIdx.x);
            pg8::EpiOut E{XR, args.in[I_XP], args.in[I_XS], l == 0 ? (const bf16*)nullptr : XR, ada_l + 8192, DN_ALPHA};
            pg8::gemm_phase<pg8::EpiOut, pg8::StaticOrder, true, true>(lds + RING_OFF, g, S, E, wv); }
        GRID_BAR();
        { IDS();
            const float* g = args.in[I_LNG] + l * DM; const float* b = args.in[I_LNB] + l * DM;
            if (l == 0) { const float* ada_n = (const float*)(ws + WS_ADA) + (size_t)3 * 12288;
                LAS unsigned char* buf = lds + wave * 16384; int m = gw; if (m < M) row_dma<8>(XR + (size_t)m * DM, buf, lane);
                for (; m < M; m += NGW) { v2u r[16];
                  asm volatile("s_waitcnt vmcnt(0)" ::: "memory"); row_lds_bf16(buf, lane, r); asm volatile("s_waitcnt lgkmcnt(0)" ::: "memory");
                  if (m + NGW < M) row_dma<8>(XR + (size_t)(m + NGW) * DM, buf, lane);
                  ln_final_mod_apply(r, g, b, XR + (size_t)m * DM, ada_n + (size_t)cond_of_row(m) * 12288, HM + (size_t)m * DM, lane); } }
            else { LAS unsigned char* buf = lds + wave * 16384; int m = gw; if (m < M) row_dma<8>(XR + (size_t)m * DM, buf, lane);
                for (; m < M; m += NGW) { v2u r[16];
                  asm volatile("s_waitcnt vmcnt(0)" ::: "memory"); row_lds_bf16(buf, lane, r); asm volatile("s_waitcnt lgkmcnt(0)" ::: "memory");
                  if (m + NGW < M) row_dma<8>(XR + (size_t)(m + NGW) * DM, buf, lane);
                  ln_final_apply(r, g, b, args.out + (size_t)m * DM, lane); } } }
        if (l + 1 < DEPTH) GRID_BAR();
    }
#undef IDS
#undef GRID_BAR
}

extern "C" void kernel_launch(void* const* d_in, const int* in_sizes, int n_in, void* d_out, int out_size, void* d_ws, size_t ws_size, hipStream_t stream) {
    static int grid = 0;
    if (grid == 0) {
        if (n_in != N_IN || (size_t)out_size != O_END || ws_size < WS_END) { fprintf(stderr, "kernel_launch: unexpected shapes: n_in %d out %d ws %zu (need %zu)\n", n_in, out_size, ws_size, (size_t)WS_END); grid = -1; return; }
        int dev = 0, cus = 0;
        if (hipGetDevice(&dev) != hipSuccess || hipDeviceGetAttribute(&cus, hipDeviceAttributeMultiprocessorCount, dev) != hipSuccess) { grid = -1; return; }
        if (hipFuncSetAttribute((const void*)fwd, hipFuncAttributeMaxDynamicSharedMemorySize, LDS_BYTES) != hipSuccess) { fprintf(stderr, "kernel_launch: hipFuncSetAttribute failed\n"); grid = -1; return; }
        int per_cu = 0;
        if (hipOccupancyMaxActiveBlocksPerMultiprocessor(&per_cu, (const void*)fwd, NTHREADS, LDS_BYTES) != hipSuccess || per_cu < 1) fprintf(stderr, "kernel_launch: note: occupancy query reports %d\n", per_cu);
        (void)hipGetLastError();
        grid = cus;
    }
    if (grid < 0) return;
    (void)hipMemsetAsync((char*)d_ws + WS_CTL, 0, CTL_ZERO_BYTES, stream);
    Args a{};
    for (int i = 0; i < N_IN; ++i) a.in[i] = (const float*)d_in[i];
    a.out = (float*)d_out; a.ws = (unsigned char*)d_ws;
    hipLaunchKernelGGL(fwd, dim3(grid), dim3(NTHREADS), LDS_BYTES, stream, a);
    const hipError_t le = hipPeekAtLastError();
    if (le != hipSuccess) fprintf(stderr, "kernel_launch: launch failed: %s\n", hipGetErrorName(le));
}
```

```cpp
#include <hip/hip_runtime.h>
#include <cstdio>
#include <cstdint>
__device__ __forceinline__ int lane_id() { int l; asm volatile("v_mbcnt_lo_u32_b32 %0, -1, 0\n\tv_mbcnt_hi_u32_b32 %0, -1, %0" : "=v"(l)); return l; }
__device__ __forceinline__ int tid_of(int wv) { return (wv << 6) | lane_id(); }
namespace pg8 {
#define PG8_LAS __attribute__((address_space(3)))
typedef unsigned short bf16_t;
typedef short bf16x8 __attribute__((ext_vector_type(8)));
typedef float f32x4 __attribute__((ext_vector_type(4)));
typedef unsigned u32x4 __attribute__((ext_vector_type(4)));
constexpr int BM = 256, BK = 64, HALF = 128, HTB = HALF * BK * 2  , STAGE_BYTES = 8 * HTB, NXCD = 8, WGM = 8;

__host__ __device__ __forceinline__ int lds_byte(int r, int c) { const int st = (r >> 4) * 2 + (c >> 5), rr = r & 15, cc = c & 31, ob = rr * 64 + cc * 2; return st * 1024 + (ob ^ (((ob >> 9) & 1) << 5)); }
__host__ __device__ __forceinline__ void stage_rc(int b, int& R, int& C) { const int st = b / 1024, sb = b % 1024, swz = sb ^ (((sb >> 9) & 1) << 5); R = (st >> 1) * 16 + swz / 64; C = (st & 1) * 32 + (swz % 64) / 2; }
__host__ __device__ __forceinline__ int perm32(int rho) { const int n = rho >> 4, i = rho & 15; return 8 * (i >> 2) + 4 * n + (i & 3); }

struct Unit { int pm, pn; };
struct Gemm { const bf16_t* A; const bf16_t* Bt; int M, N, K; };

struct StaticOrder {
    int nM, nN, nwg, G, c;
    __host__ __device__ void init(int M, int N, int G_, int c_) { nM = M / BM; nN = N / BM; nwg = nM * nN; G = G_; c = c_; }
    __host__ __device__ bool next(int i, Unit& u) const {
        const long L = (long)i * G + c; if (L >= nwg) return false;
        int wgid = (int)L; { const int q = nwg / NXCD, r = nwg % NXCD, xcd = wgid % NXCD, off = wgid / NXCD; wgid = (xcd < r ? xcd * (q + 1) : r * (q + 1) + (xcd - r) * q) + off; }
        const int nig = WGM * nN, gid = wgid / nig, fm = gid * WGM, gsz = (nM - fm) < WGM ? (nM - fm) : WGM;
        u.pm = fm + ((wgid % nig) % gsz); u.pn = (wgid % nig) / gsz; return true;
    }
    __device__ __forceinline__ void a_ready(const Unit&) const {}
    __device__ __forceinline__ void done(const Unit&) const {}
};

__device__ __forceinline__ unsigned cvt_pk_bf16(float lo, float hi) { unsigned r; asm volatile("v_cvt_pk_bf16_f32 %0, %1, %2" : "=v"(r) : "v"(lo), "v"(hi)); return r; }
typedef float f32x2 __attribute__((ext_vector_type(2)));
__device__ __forceinline__ f32x2 gelu_pk(f32x2 v) {
    const f32x2 av = __builtin_elementwise_abs(v), d = av * 0.2316418882f + 1.0f;
    f32x2 t; t.x = __builtin_amdgcn_rcpf(d.x); t.y = __builtin_amdgcn_rcpf(d.y);
    f32x2 q = t * 0.5307027145f + (-0.7265760135f); q = q * t + 0.7107068705f; q = q * t + (-0.142248368f); q = q * t + 0.127414796f; q = q * t;
    const f32x2 s = (v * v) * (-0.72134752044f);
    f32x2 e; e.x = __builtin_amdgcn_exp2f(s.x); e.y = __builtin_amdgcn_exp2f(s.y);
    const f32x2 m = v * (q * e), r = v - m;
    f32x2 o; o.x = v.x < 0.f ? m.x : r.x; o.y = v.y < 0.f ? m.y : r.y; return o;
}

template <int ACT  > struct EpiBf16 {
    static constexpr bool PERM = true, AFTER_DRAIN = false; static_assert(ACT == 0 || ACT == 1, "EpiBf16: ACT is 0 (none) or 1 (gelu_pk)");
    bf16_t* O; int ldc; const float* bias; int split_cols; size_t split_stride; float scale0;
    __device__ __forceinline__ void operator()(const f32x4 (&acc)[2][2][4][2], const Unit& u, int wr, int wc, int fr, int fq) const {
        const int row0 = u.pm * BM + wr * 64 + fr; int colt = u.pn * BM; bf16_t* base = O;
        float sc = 1.f; if (split_cols) { const int t = colt / split_cols; base += (size_t)t * split_stride; colt -= t * split_cols; if (t == 0) sc = scale0; }
        const int col0 = colt + wc * 32 + 8 * fq, bcol0 = u.pn * BM + wc * 32 + 8 * fq;
        f32x4 bv[2][2];
#pragma unroll
        for (int bj = 0; bj < 2; ++bj)
#pragma unroll
            for (int n = 0; n < 2; ++n) bv[bj][n] = bias ? *(const f32x4*)(bias + bcol0 + bj * HALF + 4 * n) : (f32x4){0.f, 0.f, 0.f, 0.f};
#pragma unroll
        for (int ai = 0; ai < 2; ++ai)
#pragma unroll
            for (int m = 0; m < 4; ++m) { bf16_t* rowp = base + (size_t)(row0 + ai * HALF + m * 16) * ldc + col0;
#pragma unroll
                for (int bj = 0; bj < 2; ++bj) { f32x4 v0 = acc[ai][bj][m][0] + bv[bj][0], v1 = acc[ai][bj][m][1] + bv[bj][1];
                    if (ACT == 1) { f32x2 a = gelu_pk((f32x2){v0[0], v0[1]}), b = gelu_pk((f32x2){v0[2], v0[3]}), c = gelu_pk((f32x2){v1[0], v1[1]}), d = gelu_pk((f32x2){v1[2], v1[3]});
                        v0 = (f32x4){a.x, a.y, b.x, b.y}; v1 = (f32x4){c.x, c.y, d.x, d.y}; }
                    v0 = v0 * sc; v1 = v1 * sc; u32x4 w; w.x = cvt_pk_bf16(v0[0], v0[1]); w.y = cvt_pk_bf16(v0[2], v0[3]); w.z = cvt_pk_bf16(v1[0], v1[1]); w.w = cvt_pk_bf16(v1[2], v1[3]);
                    *(u32x4*)(rowp + bj * HALF) = w; } }
    }
};

__device__ __forceinline__ float bf_lo(unsigned w) { return __uint_as_float(w << 16); }
__device__ __forceinline__ float bf_hi(unsigned w) { return __uint_as_float(w & 0xffff0000u); }
__device__ __forceinline__ float sigmoid_f(float x) { return __builtin_amdgcn_rcpf(1.f + __expf(-x)); }
__device__ __forceinline__ float silu_f(float x) { return x * __builtin_amdgcn_rcpf(1.f + __expf(-x)); }
struct EpiGlu {
    static constexpr bool PERM = true, AFTER_DRAIN = false;
    bf16_t* MIX; const bf16_t* Y; const bf16_t* PROJ; const float* bias; int ld_mix, ld_y, ld_proj, mix_col0, gate_col0;
    __device__ __forceinline__ void operator()(const f32x4 (&acc)[2][2][4][2], const Unit& u, int wr, int wc, int fr, int fq) const {
        const int row0 = u.pm * BM + wr * 64 + fr, col0 = u.pn * BM + wc * 32 + 8 * fq;
#pragma unroll
        for (int ai = 0; ai < 2; ++ai)
#pragma unroll
            for (int m = 0; m < 4; ++m) { const size_t row = (size_t)(row0 + ai * HALF + m * 16);
#pragma unroll
                for (int bj = 0; bj < 2; ++bj) { const int c = col0 + bj * HALF;
                    const f32x4 b0 = *(const f32x4*)(bias + c), b1 = *(const f32x4*)(bias + c + 4);
                    const u32x4 yv = *(const u32x4*)(Y + row * ld_y + c), gv = *(const u32x4*)(PROJ + row * ld_proj + gate_col0 + c);
                    const f32x4 v0 = acc[ai][bj][m][0] + b0, v1 = acc[ai][bj][m][1] + b1;
                    float o[8]; const float z[8] = {v0[0], v0[1], v0[2], v0[3], v1[0], v1[1], v1[2], v1[3]};
                    const unsigned yw[4] = {yv.x, yv.y, yv.z, yv.w}, gw[4] = {gv.x, gv.y, gv.z, gv.w};
#pragma unroll
                    for (int j = 0; j < 4; ++j) { o[2 * j] = bf_lo(yw[j]) * sigmoid_f(z[2 * j]) * silu_f(bf_lo(gw[j])); o[2 * j + 1] = bf_hi(yw[j]) * sigmoid_f(z[2 * j + 1]) * silu_f(bf_hi(gw[j])); }
                    u32x4 w; w.x = cvt_pk_bf16(o[0], o[1]); w.y = cvt_pk_bf16(o[2], o[3]); w.z = cvt_pk_bf16(o[4], o[5]); w.w = cvt_pk_bf16(o[6], o[7]);
                    *(u32x4*)(MIX + row * ld_mix + mix_col0 + c) = w; } }
    }
};
struct EpiOut {
    static constexpr bool PERM = true, AFTER_DRAIN = false;
    bf16_t* XR; const float* xc; const float* xl; const bf16_t* x16; const float* gate; float alpha;
    __device__ __forceinline__ void operator()(const f32x4 (&acc)[2][2][4][2], const Unit& u, int wr, int wc, int fr, int fq) const {
        const int row0 = u.pm * BM + wr * 64 + fr, col0 = u.pn * BM + wc * 32 + 8 * fq;
        const int v = u.pm < 32 ? 0 : 1 + ((u.pm - 32) >> 4);
        const float* xb = u.pm < 32 ? xc : xl; const int rsub = u.pm < 32 ? 0 : 8192;
#pragma unroll
        for (int bj = 0; bj < 2; ++bj) {
            const f32x4 g0 = *(const f32x4*)(gate + (size_t)v * 12288 + col0 + bj * HALF), g1 = *(const f32x4*)(gate + (size_t)v * 12288 + col0 + bj * HALF + 4);
#pragma unroll
            for (int ai = 0; ai < 2; ++ai)
#pragma unroll
                for (int m = 0; m < 4; ++m) { const size_t off = (size_t)(row0 + ai * HALF + m * 16) * 4096 + col0 + bj * HALF; f32x4 x0, x1;
                    if (x16) { const u32x4 w = *(const u32x4*)(x16 + off); x0 = (f32x4){bf_lo(w.x), bf_hi(w.x), bf_lo(w.y), bf_hi(w.y)}; x1 = (f32x4){bf_lo(w.z), bf_hi(w.z), bf_lo(w.w), bf_hi(w.w)}; }
                    else { const float* xp = xb + (off - (size_t)rsub * 4096); x0 = *(const f32x4*)xp; x1 = *(const f32x4*)(xp + 4); }
                    const f32x4 o0 = x0 * alpha + g0 * acc[ai][bj][m][0], o1 = x1 * alpha + g1 * acc[ai][bj][m][1];
                    u32x4 w; w.x = cvt_pk_bf16(o0[0], o0[1]); w.y = cvt_pk_bf16(o0[2], o0[3]); w.z = cvt_pk_bf16(o1[0], o1[1]); w.w = cvt_pk_bf16(o1[2], o1[3]);
                    *(u32x4*)(XR + off) = w;
                    if (m & 1) asm volatile("" ::: "memory"); }
        }
    }
};
template <class Epi, class Sched, bool ALIGN_EPI = false, bool SP2 = false>
__device__ __forceinline__ void gemm_phase(PG8_LAS unsigned char* lds, const Gemm g, const Sched& S, const Epi& E, int wv) {
    int tid = tid_of(wv); asm volatile("" : "+v"(tid));
    const int wid = __builtin_amdgcn_readfirstlane(tid >> 6), lane = tid & 63, wr = wid >> 2, wc = wid & 3, fr = lane & 15, fq = lane >> 4;
    const int K = g.K, nt = K / BK;
    unsigned voffA[2], voffB[2];
#pragma unroll
    for (int i = 0; i < 2; ++i) { int R, C; stage_rc(tid * 16 + i * 8192, R, C); const int Rb = Epi::PERM ? ((R & ~31) + perm32(R & 31)) : R;
        voffA[i] = (unsigned)(R * K + C) * 2u; voffB[i] = (unsigned)(Rb * K + C) * 2u; }
    const size_t kstep = (size_t)(BK * 2);
    const size_t hstep = (size_t)HALF * K * 2;
    const size_t tstep = 2 * hstep;
    const unsigned ldsw = (unsigned)wid * 1024u;
    const int aoff = lds_byte(wr * 64 + fr, fq * 8), boff = lds_byte(wc * 32 + fr, fq * 8);
#define PG8_SA(b, h) (((b) * 2 + (h)) * HTB)
#define PG8_SB(b, h) ((4 + (b) * 2 + (h)) * HTB)
#define PG8_STAGE(bufoff, gbase, voff) do { _Pragma("unroll") for (int _i = 0; _i < 2; ++_i) \
        __builtin_amdgcn_global_load_lds((const unsigned*)((const char*)(gbase) + (voff)[_i]), (PG8_LAS unsigned*)(lds + (bufoff) + ldsw + _i * 8192), 16, 0, 0); } while (0)
#define PG8_LDA(dst, b, h) do { _Pragma("unroll") for (int m = 0; m < 4; ++m) _Pragma("unroll") for (int k = 0; k < 2; ++k) dst[m][k] = *(const PG8_LAS bf16x8*)(lds + PG8_SA(b, h) + aoff + m * 2048 + k * 1024); } while (0)
#define PG8_LDB(dst, b, h) do { _Pragma("unroll") for (int n = 0; n < 2; ++n) _Pragma("unroll") for (int k = 0; k < 2; ++k) dst[n][k] = *(const PG8_LAS bf16x8*)(lds + PG8_SB(b, h) + boff + n * 2048 + k * 1024); } while (0)
#define PG8_MMA(ai, bj, At, Bt) do { __builtin_amdgcn_s_setprio(1); _Pragma("unroll") for (int m = 0; m < 4; ++m) _Pragma("unroll") for (int n = 0; n < 2; ++n) _Pragma("unroll") for (int k = 0; k < 2; ++k) \
        acc[ai][bj][m][n] = __builtin_amdgcn_mfma_f32_16x16x32_bf16(Bt[n][k], At[m][k], acc[ai][bj][m][n], 0, 0, 0); __builtin_amdgcn_s_setprio(0); } while (0)
#define PG8_WAIT_V(n) asm volatile("s_waitcnt vmcnt(" #n ")" ::: "memory")
#define PG8_WAIT_L(n) asm volatile("s_waitcnt lgkmcnt(" #n ")" ::: "memory")
#define PG8_BAR __builtin_amdgcn_s_barrier()
#define PG8_SCHED __builtin_amdgcn_sched_barrier(0)
    Unit cur, nxt; int ui = 0;
    if (!S.next(0, cur)) return;
    f32x4 acc[2][2][4][2];
#pragma unroll
    for (int a = 0; a < 2; ++a)
#pragma unroll
        for (int b = 0; b < 2; ++b)
#pragma unroll
            for (int m = 0; m < 4; ++m)
#pragma unroll
                for (int n = 0; n < 2; ++n) acc[a][b][m][n] = (f32x4){0.f, 0.f, 0.f, 0.f};
    bf16x8 At[4][2], B0[2][2], B1[2][2];
    const char* cA = (const char*)g.A + (size_t)cur.pm * tstep; const char* cB = (const char*)g.Bt + (size_t)cur.pn * tstep;
    S.a_ready(cur);
    if constexpr (SP2) {
        PG8_STAGE(PG8_SB(0, 0), cB, voffB); PG8_STAGE(PG8_SB(0, 1), cB + hstep, voffB); PG8_STAGE(PG8_SA(0, 0), cA, voffA); PG8_STAGE(PG8_SA(0, 1), cA + hstep, voffA);
        if (wr == 1) PG8_BAR;
        PG8_WAIT_V(2); PG8_BAR;
        PG8_STAGE(PG8_SB(1, 0), cB + kstep, voffB); PG8_STAGE(PG8_SA(1, 0), cA + kstep, voffA); PG8_STAGE(PG8_SB(1, 1), cB + hstep + kstep, voffB);
        PG8_WAIT_V(6); PG8_BAR;
    } else {
        PG8_STAGE(PG8_SB(0, 0), cB, voffB); PG8_STAGE(PG8_SA(0, 0), cA, voffA); PG8_STAGE(PG8_SB(0, 1), cB + hstep, voffB); PG8_STAGE(PG8_SA(0, 1), cA + hstep, voffA);
        if (wr == 1) PG8_BAR;
        PG8_WAIT_V(4); PG8_BAR;
        PG8_STAGE(PG8_SB(1, 0), cB + kstep, voffB); PG8_STAGE(PG8_SA(1, 0), cA + kstep, voffA); PG8_STAGE(PG8_SB(1, 1), cB + hstep + kstep, voffB);
        PG8_WAIT_V(6); PG8_BAR;
    }
    for (;;) {
        const bool has_next = S.next(ui + 1, nxt);
        const char* nA = has_next ? (const char*)g.A + (size_t)nxt.pm * tstep : cA; const char* nB = has_next ? (const char*)g.Bt + (size_t)nxt.pn * tstep : cB;
        for (int t = 0; t < nt; t += 2) {
            const bool last = (t == nt - 2);
            const char* a1 = cA + (size_t)(t + 1) * kstep;
            const char* a2 = last ? nA : cA + (size_t)(t + 2) * kstep; const char* b2 = last ? nB : cB + (size_t)(t + 2) * kstep;
            const char* a3 = a2 + kstep; const char* b3 = b2 + kstep;
            if (last && has_next) S.a_ready(nxt);
            if constexpr (SP2) {
            PG8_LDB(B0, 0, 0); PG8_LDB(B1, 0, 1); PG8_SCHED; PG8_LDA(At, 0, 0); PG8_STAGE(PG8_SA(1, 1), a1 + hstep, voffA);
            PG8_WAIT_V(8); PG8_WAIT_L(0); PG8_BAR; PG8_MMA(0, 0, At, B0); PG8_MMA(0, 1, At, B1); PG8_BAR; PG8_SCHED;
            PG8_LDA(At, 0, 1); PG8_STAGE(PG8_SB(0, 0), b2, voffB); PG8_STAGE(PG8_SB(0, 1), b2 + hstep, voffB); PG8_STAGE(PG8_SA(0, 0), a2, voffA);
            PG8_WAIT_V(8); PG8_WAIT_L(0); PG8_BAR; PG8_MMA(1, 0, At, B0); PG8_MMA(1, 1, At, B1); PG8_BAR; PG8_SCHED;
            PG8_LDB(B0, 1, 0); PG8_LDB(B1, 1, 1); PG8_SCHED; PG8_LDA(At, 1, 0); PG8_STAGE(PG8_SA(0, 1), a2 + hstep, voffA);
            PG8_WAIT_V(8); PG8_WAIT_L(0); PG8_BAR; PG8_MMA(0, 0, At, B0); PG8_MMA(0, 1, At, B1); PG8_BAR; PG8_SCHED;
            PG8_LDA(At, 1, 1); PG8_STAGE(PG8_SB(1, 0), b3, voffB); PG8_STAGE(PG8_SB(1, 1), b3 + hstep, voffB); PG8_STAGE(PG8_SA(1, 0), a3, voffA);
            PG8_WAIT_V(8); PG8_WAIT_L(0); PG8_BAR; PG8_MMA(1, 0, At, B0); PG8_MMA(1, 1, At, B1); PG8_BAR; PG8_SCHED;
            } else {
            PG8_LDB(B0, 0, 0); PG8_SCHED; PG8_LDA(At, 0, 0); PG8_STAGE(PG8_SA(1, 1), a1 + hstep, voffA);
            PG8_WAIT_L(8); PG8_BAR; PG8_WAIT_L(0); PG8_MMA(0, 0, At, B0); PG8_BAR; PG8_SCHED;
            PG8_LDB(B1, 0, 1); PG8_STAGE(PG8_SB(0, 0), b2, voffB);
            PG8_BAR; PG8_WAIT_L(0); PG8_MMA(0, 1, At, B1); PG8_BAR;
            PG8_LDA(At, 0, 1); PG8_STAGE(PG8_SA(0, 0), a2, voffA);
            PG8_BAR; PG8_WAIT_L(0); PG8_MMA(1, 0, At, B0); PG8_BAR; PG8_SCHED;
            PG8_STAGE(PG8_SB(0, 1), b2 + hstep, voffB);
            PG8_WAIT_V(6); PG8_BAR; PG8_MMA(1, 1, At, B1); PG8_BAR;
            PG8_LDB(B0, 1, 0); PG8_SCHED; PG8_LDA(At, 1, 0); PG8_STAGE(PG8_SA(0, 1), a2 + hstep, voffA);
            PG8_WAIT_L(8); PG8_BAR; PG8_WAIT_L(0); PG8_MMA(0, 0, At, B0); PG8_BAR; PG8_SCHED;
            PG8_LDB(B1, 1, 1); PG8_STAGE(PG8_SB(1, 0), b3, voffB);
            PG8_BAR; PG8_WAIT_L(0); PG8_MMA(0, 1, At, B1); PG8_BAR;
            PG8_LDA(At, 1, 1); PG8_STAGE(PG8_SA(1, 0), a3, voffA);
            PG8_BAR; PG8_WAIT_L(0); PG8_MMA(1, 0, At, B0); PG8_BAR; PG8_SCHED;
            PG8_STAGE(PG8_SB(1, 1), b3 + hstep, voffB);
            PG8_WAIT_V(6); PG8_BAR; PG8_MMA(1, 1, At, B1); PG8_BAR;
            }
        }
        if constexpr (ALIGN_EPI) { if (wr == 0) PG8_BAR; }
        if constexpr (!Epi::AFTER_DRAIN) { E(acc, cur, wr, wc, fr, fq); S.done(cur); }
        if (!has_next) break;
#pragma unroll
        for (int a = 0; a < 2; ++a)
#pragma unroll
            for (int b = 0; b < 2; ++b)
#pragma unroll
                for (int m = 0; m < 4; ++m)
#pragma unroll
                    for (int n = 0; n < 2; ++n) acc[a][b][m][n] = (f32x4){0.f, 0.f, 0.f, 0.f};
        cur = nxt; cA = nA; cB = nB; ++ui;
        if constexpr (ALIGN_EPI) { if (wr == 1) PG8_BAR; }
    }
    PG8_WAIT_V(0);
    if constexpr (!ALIGN_EPI) { if (wr == 0) PG8_BAR; }
    PG8_BAR;
    if constexpr (Epi::AFTER_DRAIN) { E.fused(acc, cur, wr, wc, fr, fq, lds, wid, lane); S.done(cur); }
#undef PG8_SA
#undef PG8_SB
#undef PG8_STAGE
#undef PG8_LDA
#undef PG8_LDB
#undef PG8_MMA
#undef PG8_WAIT_V
#undef PG8_WAIT_L
#undef PG8_BAR
#undef PG8_SCHED
}
}
constexpr int DM = 4096, SEQ = 256, LSEQ = 4096, DEPTH = 2;
constexpr int MC = 8192, M = 16384;
constexpr int DIN = 11264;
constexpr int A_Q = 0, A_K = 1024, A_V = 2048, A_G = 3072, B_Q = 4096, B_K = 5120, B_V = 5376, B_G = 5632, C_U = 6656, C_G = 7680, D_Q = 8704, D_K = 9728, D_V = 9984, D_G = 10240;
constexpr float LN_EPS = 1e-5f, RMS_EPS = 1e-6f, DN_ALPHA = 1.41421356237f;
constexpr size_t MiB = 1u << 20;
constexpr size_t WS_CTL = 0, CTL_ZERO_BYTES = 1 * MiB;
constexpr size_t WS_ADA = 1 * MiB;
constexpr size_t WS_ROPE = 2 * MiB;
constexpr size_t WS_ROPEA = 2 * MiB + 32768;
constexpr size_t WS_LAM = 2 * MiB + 65536;
constexpr size_t WS_S5A = 3 * MiB;
constexpr size_t WS_S5BB = 4 * MiB;
constexpr size_t WS_CAK = 8 * MiB, WS_CAV = 10 * MiB, WS_CBK = 12 * MiB, WS_CBV = 12 * MiB + 512 * 1024, WS_CDK = 13 * MiB, WS_CDV = 13 * MiB + 512 * 1024;
constexpr size_t WS_WIN = 16 * MiB;
constexpr size_t WS_WOUT = 192 * MiB;
constexpr size_t WS_GLU = 256 * MiB;
constexpr size_t WS_HM = 264 * MiB;
constexpr size_t WS_PROJ = 392 * MiB;
constexpr size_t WS_YACT = 744 * MiB;
constexpr size_t WS_YD = 776 * MiB;
constexpr size_t WS_XR = 904 * MiB;
constexpr size_t WS_SEG = 1156 * MiB;
constexpr size_t WS_ASCR = 1160 * MiB;
constexpr size_t WS_END = 1192 * MiB;
constexpr int CW_BAR = 4096;
constexpr size_t O_AK = (size_t)M * DM, O_AV = O_AK + 16777216, O_BK = O_AV + 16777216, O_BV = O_BK + 4194304, O_DK = O_BV + 4194304, O_DV = O_DK + 4194304, O_CRE = O_DV + 4194304, O_CIM = O_CRE + 524288, O_END = O_CIM + 524288;
constexpr int RING_OFF = 0, RING_BYTES = 131072;
constexpr int LDSCTL_OFF = RING_BYTES, MISC_OFF = LDSCTL_OFF + 320;
constexpr int LDS_BYTES = 147456;
constexpr int NWAVES = 8, NTHREADS = 512;

#define GAS __attribute__((address_space(1)))
#define LAS __attribute__((address_space(3)))
typedef unsigned short bf16;
typedef unsigned v4u __attribute__((ext_vector_type(4)));
typedef unsigned v2u __attribute__((ext_vector_type(2)));
typedef float f32x4 __attribute__((ext_vector_type(4)));
typedef GAS unsigned gu32;
#define RLX_AGENT __ATOMIC_RELAXED, __HIP_MEMORY_SCOPE_AGENT
#define LDS_WAIT() asm volatile("s_waitcnt lgkmcnt(0)" ::: "memory")
__device__ __forceinline__ unsigned f2bf(float f) { unsigned u = __builtin_bit_cast(unsigned, f); return (u + 0x7fffu + ((u >> 16) & 1u)) >> 16; }
__device__ __forceinline__ unsigned pk2(float lo, float hi) { unsigned r; asm("v_cvt_pk_bf16_f32 %0, %1, %2" : "=v"(r) : "v"(lo), "v"(hi)); return r; }
__device__ __forceinline__ float bf2f(bf16 b) { return __uint_as_float(((unsigned)b) << 16); }
__device__ __forceinline__ float blo(unsigned w) { return __uint_as_float(w << 16); }
__device__ __forceinline__ float bhi(unsigned w) { return __uint_as_float(w & 0xffff0000u); }
__device__ __forceinline__ float siluf(float x) { return x * __builtin_amdgcn_rcpf(1.f + __expf(-x)); }
__device__ __forceinline__ float gelu_tanh(float x) { const float u = 0.7978845608028654f * (x + 0.044715f * x * x * x); const float e = __expf(2.f * u); const float t = 1.f - 2.f * __builtin_amdgcn_rcpf(e + 1.f); return 0.5f * x * (1.f + t); }
template <int CTRL> __device__ __forceinline__ float dpp_f(float v) { return __builtin_bit_cast(float, __builtin_amdgcn_update_dpp(0, __builtin_bit_cast(int, v), CTRL, 0xF, 0xF, true)); }
__device__ __forceinline__ float red4(float v) { v += dpp_f<0xB1>(v); v += dpp_f<0x4E>(v); return v; }
__device__ __forceinline__ float red8(float v) { v = red4(v); v += dpp_f<0x141>(v); return v; }
__device__ __forceinline__ float red16(float v) { v = red8(v); v += dpp_f<0x140>(v); return v; }
__device__ __forceinline__ float red32(float v) { v = red16(v); v += __builtin_bit_cast(float, __builtin_amdgcn_ds_swizzle(__builtin_bit_cast(int, v), 0x401F)); return v; }
__device__ __forceinline__ float wave_sum(float v) { v = red32(v); const auto rr = __builtin_amdgcn_permlane32_swap(__float_as_uint(v), __float_as_uint(v), false, false); return __uint_as_float(rr[0]) + __uint_as_float(rr[1]); }
#define XB_TMO      128
#define XB_XCNT(j)  (256  + 64 * (j))
#define XB_XSUB(j)  (1280 + 64 * (j))
#define XB_XGEN(j)  (2304 + 64 * (j))
#define XB_TOP      3328
#define XB_TOPGEN   3392
#define XCD_BAR_WORDS 3456
#define XB_SPIN_CAP (1u << 18)

__device__ __forceinline__ unsigned xb_ld(unsigned* p)              { return __hip_atomic_load(p, __ATOMIC_RELAXED, __HIP_MEMORY_SCOPE_AGENT); }
__device__ __forceinline__ unsigned xb_add(unsigned* p, unsigned v) { return __hip_atomic_fetch_add(p, v, __ATOMIC_RELAXED, __HIP_MEMORY_SCOPE_AGENT); }
__device__ __forceinline__ unsigned xb_xcc_id() { return (unsigned)__builtin_amdgcn_s_getreg((3 << 11) | 20) & 0xFu; }
#define XB_SPIN(cond, bar) do { unsigned _sp = 0; while (cond) { __builtin_amdgcn_s_sleep(1); \
    if ((++_sp & 255u) == 0u) { if (xb_ld(&(bar)[XB_TMO])) break; if (_sp > XB_SPIN_CAP) { atomicAdd(&(bar)[XB_TMO], 1u); break; } } } } while (0)

struct XcdBarrier {
    unsigned* bar; unsigned x;
    volatile LAS unsigned* st;
};

__device__ __forceinline__ XcdBarrier xcd_barrier_post(unsigned* bar, volatile LAS unsigned* st, bool leader) {
    XcdBarrier b; b.bar = bar; b.x = xb_xcc_id(); b.st = st;
    if (leader) (void)xb_add(&bar[XB_XCNT(b.x)], 1u);
    return b;
}
__device__ __forceinline__ void xcd_barrier_complete(unsigned* bar, unsigned x, unsigned& nloc, unsigned& nx) {
    const unsigned G = gridDim.x * gridDim.y * gridDim.z;
    unsigned sum, cnt, mine, sp = 0u;
    for (;;) {
        sum = 0u; cnt = 0u; mine = 0u;
#pragma unroll
        for (unsigned j = 0; j < 16; ++j) { const unsigned c = xb_ld(&bar[XB_XCNT(j)]); sum += c; cnt += (c > 0u) ? 1u : 0u; mine = (j == x) ? c : mine; }
        if (sum == G) break;
        __builtin_amdgcn_s_sleep(1);
        if ((++sp & 255u) == 0u) { if (xb_ld(&bar[XB_TMO])) break; if (sp > XB_SPIN_CAP) { atomicAdd(&bar[XB_TMO], 1u); break; } }
    }
    nloc = mine > 0u ? mine : 1u; nx = cnt > 0u ? cnt : 1u;
}

__device__ __forceinline__ void xcd_barrier(const XcdBarrier& b, bool leader) {
    asm volatile("s_waitcnt vmcnt(0)" ::: "memory");
    __syncthreads();
    if (leader) {
        unsigned* bar = b.bar;
        __builtin_amdgcn_s_waitcnt(0);
        unsigned nloc = b.st[0], nx = b.st[1];
        if (nloc == 0u) { xcd_barrier_complete(bar, b.x, nloc, nx); b.st[0] = nloc; b.st[1] = nx; }
        const unsigned old = xb_add(&bar[XB_XSUB(b.x)], 1u);
        const unsigned gen = old / nloc;
        if (old + 1u == (gen + 1u) * nloc) {
            __builtin_amdgcn_fence(__ATOMIC_RELEASE, "agent");
            asm volatile("s_waitcnt vmcnt(0)" ::: "memory");
            const unsigned og = xb_add(&bar[XB_TOP], 1u);
            const unsigned tg = og / nx;
            if (og + 1u == (tg + 1u) * nx) xb_add(&bar[XB_TOPGEN], 1u);
            else XB_SPIN(xb_ld(&bar[XB_TOPGEN]) == tg, bar);
            __builtin_amdgcn_fence(__ATOMIC_ACQUIRE, "agent");
            xb_add(&bar[XB_XGEN(b.x)], 1u);
            asm volatile("s_waitcnt vmcnt(0)" ::: "memory");
        } else {
            XB_SPIN(xb_ld(&bar[XB_XGEN(b.x)]) == gen, bar);
            __builtin_amdgcn_fence(__ATOMIC_ACQUIRE, "agent");
            asm volatile("s_waitcnt vmcnt(0)" ::: "memory");
        }
    }
    __syncthreads();
}
enum { I_XP = 0, I_XS, I_C, I_CAK, I_CAV, I_CBK, I_CBV, I_CDK, I_CDV, I_SRE, I_SIM, I_CCTX, I_WADA, I_BADA, I_WIN, I_WOUT, I_LNG, I_LNB, I_LQ1, I_LK1, I_LQ2, I_LK2, I_SUBG, I_QNG, I_KNG, I_SINK,
       I_CLRE, I_CLIM, I_CLDT, I_CBRE, I_CBIM, I_CCRE, I_CCIM, I_CD, I_GLUW, I_GLUB, N_IN };
struct Args { const float* in[N_IN]; float* out; unsigned char* ws; };
typedef const __attribute__((address_space(4))) Args CArgs;

struct TItem { const float* W; bf16* WT; int K, N, k0, n0; };
__device__ __forceinline__ void p0_item_dma(const TItem& t, LAS unsigned char* img, int lane) {
    const float* src = t.W + (size_t)(t.k0 + (lane >> 3)) * t.N + t.n0;
#pragma unroll
    for (int i = 0; i < 8; ++i) __builtin_amdgcn_global_load_lds((const unsigned*)(src + (size_t)(8 * i) * t.N + 4 * ((lane & 7) ^ i)), (LAS unsigned*)(img + i * 1024), 16, 0, 0);
}
__device__ __forceinline__ void p0_item_store(const TItem& t, const LAS unsigned char* img, int lane) {
    const int c = lane & 7; const LAS float* s = (const LAS float*)img + (8 * c) * 32;
#pragma unroll
    for (int j = 0; j < 4; ++j) { const int n = (lane >> 3) + 8 * j, o4 = (((n >> 2) ^ c) << 2) + (n & 3);
        v4u o; o.x = pk2(s[0 * 32 + o4], s[1 * 32 + o4]); o.y = pk2(s[2 * 32 + o4], s[3 * 32 + o4]); o.z = pk2(s[4 * 32 + o4], s[5 * 32 + o4]); o.w = pk2(s[6 * 32 + o4], s[7 * 32 + o4]);
        *(GAS v4u*)(t.WT + (size_t)(t.n0 + n) * t.K + t.k0 + 8 * c) = o; }
}
__device__ __forceinline__ void cvt_copy(const float* src, bf16* dst, size_t n8, size_t i0, size_t stride) {
    for (size_t i = i0; i < n8; i += stride) { const f32x4 a = *(const f32x4*)(src + 8 * i), b = *(const f32x4*)(src + 8 * i + 4);
        v4u o; o.x = pk2(a.x, a.y); o.y = pk2(a.z, a.w); o.z = pk2(b.x, b.y); o.w = pk2(b.z, b.w); *(v4u*)(dst + 8 * i) = o; }
}
__device__ __forceinline__ void p0_ada(CArgs& a, LAS unsigned char* lds, int wv) {
    int tid = tid_of(wv); asm volatile("" : "+v"(tid));
    unsigned char* ws = a.ws;
    {
        LAS float* S = (LAS float*)lds;
        LAS float* red = S + 3 * 4096;
        for (int i = tid; i < 3 * 4096; i += NTHREADS) { const int v = i >> 12, k = i & 4095; const float x = v == 0 ? a.in[I_CCTX][k] : a.in[I_C][(v - 1) * 4096 + k]; S[i] = siluf(x); }
        __syncthreads();
        const int q = tid % 24, ks = tid / 24;
        for (int grp = blockIdx.x; grp < 256; grp += gridDim.x) {
            const int l = grp >> 7, n0 = (grp & 127) * 96;
            f32x4 acc0 = {0.f, 0.f, 0.f, 0.f}, acc1 = acc0, acc2 = acc0;
            if (ks < 21) {
                const float* wp = a.in[I_WADA] + (size_t)l * 4096 * 12288 + n0 + 4 * q;
#pragma unroll 8
                for (int k = ks; k < 4096; k += 21) { const f32x4 w = *(const f32x4*)(wp + (size_t)k * 12288); acc0 += w * S[k]; acc1 += w * S[4096 + k]; acc2 += w * S[8192 + k]; }
                LAS float* r = red + (ks * 24 + q) * 12;
#pragma unroll
                for (int j = 0; j < 4; ++j) { r[j] = acc0[j]; r[4 + j] = acc1[j]; r[8 + j] = acc2[j]; }
            }
            __syncthreads();
            if (tid < 288) { const int v = tid / 96, c = tid % 96, qq = c >> 2, j = c & 3; float s = 0.f;
                for (int k2 = 0; k2 < 21; ++k2) s += red[(k2 * 24 + qq) * 12 + v * 4 + j];
                ((float*)(ws + WS_ADA))[(size_t)(l * 3 + v) * 12288 + n0 + c] = s + a.in[I_BADA][(size_t)l * 12288 + n0 + c]; }
            __syncthreads();
        }
    }
}
__device__ __forceinline__ void p0_prologue(CArgs& a, LAS unsigned char* lds, int wv) {
    int tid = tid_of(wv); asm volatile("" : "+v"(tid)); const int lane = tid & 63, wave = __builtin_amdgcn_readfirstlane(tid >> 6);
    const int gw = blockIdx.x * NWAVES + wave, NGW = gridDim.x * NWAVES;
    unsigned char* ws = a.ws;
    {
        LAS unsigned char* img = lds + wave * 16384;
        constexpr int I_IN = (DM / 64) * (DIN / 32), I_OUT = (DM / 64) * (DM / 32), I_GL = (1024 / 64) * (1024 / 32), I_L = I_IN + I_OUT + I_GL;
        auto decode = [&](int it) -> TItem { const int l = it / I_L; int r = it % I_L;
            if (r < I_IN) { const int nblk = DIN / 32; return TItem{a.in[I_WIN] + (size_t)l * DM * DIN, (bf16*)(ws + WS_WIN) + (size_t)l * DIN * DM, DM, DIN, 64 * (r / nblk), 32 * (r % nblk)}; } r -= I_IN;
            if (r < I_OUT) { const int nblk = DM / 32; return TItem{a.in[I_WOUT] + (size_t)l * DM * DM, (bf16*)(ws + WS_WOUT) + (size_t)l * DM * DM, DM, DM, 64 * (r / nblk), 32 * (r % nblk)}; } r -= I_OUT;
            const int nblk = 1024 / 32; return TItem{a.in[I_GLUW] + (size_t)l * 1024 * 1024, (bf16*)(ws + WS_GLU) + (size_t)l * 1024 * 1024, 1024, 1024, 64 * (r / nblk), 32 * (r % nblk)}; };
        int it = gw, par = 0;
        if (it < 2 * I_L) p0_item_dma(decode(it), img, lane);
        for (; it < 2 * I_L; it += NGW, par ^= 1) {
            const bool more = it + NGW < 2 * I_L;
            if (more) { p0_item_dma(decode(it + NGW), img + (par ^ 1) * 8192, lane); asm volatile("s_waitcnt vmcnt(8)" ::: "memory"); }
            else asm volatile("s_waitcnt vmcnt(0)" ::: "memory");
            p0_item_store(decode(it), img + par * 8192, lane);
            asm volatile("s_waitcnt lgkmcnt(0)" ::: "memory");
        }
    }
    {
        const size_t gt = (size_t)blockIdx.x * NTHREADS + tid, NGT = (size_t)gridDim.x * NTHREADS;
        cvt_copy(a.in[I_CAK], (bf16*)(ws + WS_CAK), 1048576 / 8, gt, NGT); cvt_copy(a.in[I_CAV], (bf16*)(ws + WS_CAV), 1048576 / 8, gt, NGT);
        cvt_copy(a.in[I_CBK], (bf16*)(ws + WS_CBK), 262144 / 8, gt, NGT);  cvt_copy(a.in[I_CBV], (bf16*)(ws + WS_CBV), 262144 / 8, gt, NGT);
        cvt_copy(a.in[I_CDK], (bf16*)(ws + WS_CDK), 262144 / 8, gt, NGT);  cvt_copy(a.in[I_CDV], (bf16*)(ws + WS_CDV), 262144 / 8, gt, NGT);
        float* rope = (float*)(ws + WS_ROPE);
        for (size_t i = gt; i < 2048; i += NGT) { const int pos = (int)(i >> 5), fi = (int)(i & 31); const float inv = exp2f(-(float)fi * (13.287712379549449f / 32.f)); const float ang = (float)pos * inv; rope[2 * i] = cosf(ang); rope[2 * i + 1] = sinf(ang); }
        { float* ropea = (float*)(ws + WS_ROPEA);
          for (size_t i = gt; i < 1024; i += NGT) { const int pos = (int)(i >> 4), fi = (int)(i & 15); const float inv = exp2f(-(float)fi * (13.287712379549449f / 16.f)); const float ang = (float)pos * inv; ropea[2 * i] = cosf(ang); ropea[2 * i + 1] = sinf(ang); } }
        float* sa_re = (float*)(ws + WS_S5A); float* sa_im = sa_re + 16384; float* sbb_re = (float*)(ws + WS_S5BB); float* sbb_im = sbb_re + 262144;
        for (size_t i = gt; i < 16384; i += NGT) {
            const float lr = a.in[I_CLRE][i], li = a.in[I_CLIM][i], dt = expf(a.in[I_CLDT][i >> 6]);
            const float mag = expf(lr * dt), th = li * dt, cs = cosf(th), sn = sinf(th);
            const float are = mag * cs, aim = mag * sn;
            const float sh = sinf(0.5f * th); const float nr = expm1f(lr * dt) * cs - 2.f * sh * sh;
            const float den = lr * lr + li * li;
            const float fre = (nr * lr + aim * li) / den, fim = (aim * lr - nr * li) / den;
            sa_re[i] = are; sa_im[i] = aim;
#pragma unroll
            for (int c = 0; c < 16; ++c) { const float br = a.in[I_CBRE][i * 16 + c], bi = a.in[I_CBIM][i * 16 + c]; sbb_re[i * 16 + c] = fre * br - fim * bi; sbb_im[i * 16 + c] = fre * bi + fim * br; }
        }
        if (gt < 2) { const int l = (int)gt; float s1 = 0.f, s2 = 0.f;
            for (int k = 0; k < 64; ++k) { s1 += a.in[I_LQ1][l * 64 + k] * a.in[I_LK1][l * 64 + k]; s2 += a.in[I_LQ2][l * 64 + k] * a.in[I_LK2][l * 64 + k]; }
            const float lam_init = l == 0 ? 0.2f : 0.35550906759f;
            ((float*)(ws + WS_LAM))[l] = expf(s1) - expf(s2) + lam_init; }
    }
}
__device__ __forceinline__ void row_norm16(f32x4 (&v)[16]) {
    float s = 0.f;
#pragma unroll
    for (int j = 0; j < 16; ++j) s += (v[j].x + v[j].y) + (v[j].z + v[j].w);
    const float mean = wave_sum(s) * (1.f / DM); float s2 = 0.f;
#pragma unroll
    for (int j = 0; j < 16; ++j) { v[j] = v[j] - mean; s2 += (v[j].x * v[j].x + v[j].y * v[j].y) + (v[j].z * v[j].z + v[j].w * v[j].w); }
    const float rstd = 1.f / sqrtf(wave_sum(s2) * (1.f / DM) + LN_EPS);
#pragma unroll
    for (int j = 0; j < 16; ++j) v[j] = v[j] * rstd;
}
__device__ __forceinline__ void row_ld_bf16(const bf16* row, int lane, f32x4 (&v)[16]) {
    const v2u* p = (const v2u*)row + lane;
#pragma unroll
    for (int j = 0; j < 16; ++j) { const v2u w = p[64 * j]; v[j] = (f32x4){blo(w.x), bhi(w.x), blo(w.y), bhi(w.y)}; }
}
__device__ __forceinline__ void row_st_bf16(bf16* row, int lane, const f32x4 (&v)[16]) {
    v2u* p = (v2u*)row + lane;
#pragma unroll
    for (int j = 0; j < 16; ++j) { v2u w; w.x = pk2(v[j].x, v[j].y); w.y = pk2(v[j].z, v[j].w); p[64 * j] = w; }
}
__device__ __forceinline__ void ln_mod_row(const float* xrow, const float* ada_v, bf16* hrow, int lane) {
    const f32x4* xr = (const f32x4*)xrow + lane; f32x4 v[16];
#pragma unroll
    for (int j = 0; j < 16; ++j) v[j] = xr[64 * j];
    row_norm16(v);
#pragma unroll
    for (int j = 0; j < 16; ++j) { const int col = 4 * (lane + 64 * j); v[j] = v[j] * (*(const f32x4*)(ada_v + 4096 + col) + 1.f) + *(const f32x4*)(ada_v + col); }
    row_st_bf16(hrow, lane, v);
}
__device__ __forceinline__ void ln_final_row(const bf16* xrow, const float* g, const float* b, float* orow, int lane) {
    f32x4 v[16]; row_ld_bf16(xrow, lane, v); row_norm16(v);
    f32x4* o = (f32x4*)orow + lane;
#pragma unroll
    for (int j = 0; j < 16; ++j) { const int col = 4 * (lane + 64 * j); o[64 * j] = v[j] * *(const f32x4*)(g + col) + *(const f32x4*)(b + col); }
}
__device__ __forceinline__ void ln_final_mod_row(const bf16* xrow, const float* g, const float* b, bf16* orow, const float* ada_v, bf16* hrow, int lane) {
    f32x4 v[16]; row_ld_bf16(xrow, lane, v); row_norm16(v);
#pragma unroll
    for (int j = 0; j < 16; ++j) { const int col = 4 * (lane + 64 * j); v[j] = v[j] * *(const f32x4*)(g + col) + *(const f32x4*)(b + col); }
    row_st_bf16(orow, lane, v);
    row_norm16(v);
#pragma unroll
    for (int j = 0; j < 16; ++j) { const int col = 4 * (lane + 64 * j); v[j] = v[j] * (*(const f32x4*)(ada_v + 4096 + col) + 1.f) + *(const f32x4*)(ada_v + col); }
    row_st_bf16(hrow, lane, v);
}
template <int NI> __device__ __forceinline__ void row_dma(const void* row, LAS unsigned char* buf, int lane) {
#pragma unroll
    for (int i = 0; i < NI; ++i) __builtin_amdgcn_global_load_lds((const unsigned*)((const char*)row + i * 1024 + lane * 16), (LAS unsigned*)(buf + i * 1024), 16, 0, 0);
}
__device__ __forceinline__ void row_lds_f32(const LAS unsigned char* buf, int lane, f32x4 (&r)[16]) { const LAS f32x4* p = (const LAS f32x4*)buf + lane;
#pragma unroll
    for (int j = 0; j < 16; ++j) r[j] = p[64 * j]; }
__device__ __forceinline__ void row_lds_bf16(const LAS unsigned char* buf, int lane, v2u (&r)[16]) { const LAS v2u* p = (const LAS v2u*)buf + lane;
#pragma unroll
    for (int j = 0; j < 16; ++j) r[j] = p[64 * j]; }
__device__ __forceinline__ void row_cvt16(const v2u (&r)[16], f32x4 (&v)[16]) {
#pragma unroll
    for (int j = 0; j < 16; ++j) v[j] = (f32x4){blo(r[j].x), bhi(r[j].x), blo(r[j].y), bhi(r[j].y)}; }
__device__ __forceinline__ void ln_mod_apply(f32x4 (&v)[16], const float* ada_v, bf16* hrow, int lane) {
    row_norm16(v);
#pragma unroll
    for (int j = 0; j < 16; ++j) { const int col = 4 * (lane + 64 * j); v[j] = v[j] * (*(const f32x4*)(ada_v + 4096 + col) + 1.f) + *(const f32x4*)(ada_v + col); }
    row_st_bf16(hrow, lane, v);
}
__device__ __forceinline__ void ln_final_apply(const v2u (&r)[16], const float* g, const float* b, float* orow, int lane) {
    f32x4 v[16]; row_cvt16(r, v); row_norm16(v);
    f32x4* o = (f32x4*)orow + lane;
#pragma unroll
    for (int j = 0; j < 16; ++j) { const int col = 4 * (lane + 64 * j); o[64 * j] = v[j] * *(const f32x4*)(g + col) + *(const f32x4*)(b + col); }
}
__device__ __forceinline__ void ln_final_mod_apply(const v2u (&r)[16], const float* g, const float* b, bf16* orow, const float* ada_v, bf16* hrow, int lane) {
    f32x4 v[16]; row_cvt16(r, v); row_norm16(v);
#pragma unroll
    for (int j = 0; j < 16; ++j) { const int col = 4 * (lane + 64 * j); v[j] = v[j] * *(const f32x4*)(g + col) + *(const f32x4*)(b + col); }
    row_st_bf16(orow, lane, v);
    row_norm16(v);
#pragma unroll
    for (int j = 0; j < 16; ++j) { const int col = 4 * (lane + 64 * j); v[j] = v[j] * (*(const f32x4*)(ada_v + 4096 + col) + 1.f) + *(const f32x4*)(ada_v + col); }
    row_st_bf16(hrow, lane, v);
}
__device__ __forceinline__ const float* x_row_in(CArgs& a, int m) { return m < MC ? a.in[I_XP] + (size_t)m * DM : a.in[I_XS] + (size_t)(m - MC) * DM; }
__device__ __forceinline__ int cond_of_row(int m) { return m < MC ? 0 : 1 + ((m - MC) >> 12); }

__device__ __forceinline__ void unpack8(const v4u w, float (&x)[8]) { x[0] = blo(w.x); x[1] = bhi(w.x); x[2] = blo(w.y); x[3] = bhi(w.y); x[4] = blo(w.z); x[5] = bhi(w.z); x[6] = blo(w.w); x[7] = bhi(w.w); }
__device__ __forceinline__ v4u pack8(const float (&x)[8]) { v4u w; w.x = pk2(x[0], x[1]); w.y = pk2(x[2], x[3]); w.z = pk2(x[4], x[5]); w.w = pk2(x[6], x[7]); return w; }
__device__ __forceinline__ void rope8(float (&x0)[8], float (&x1)[8], const float (&cs)[16]) {
#pragma unroll
    for (int t = 0; t < 8; ++t) { const float c = cs[2 * t], s = cs[2 * t + 1], y0 = x0[t] * c - x1[t] * s, y1 = x1[t] * c + x0[t] * s; x0[t] = y0; x1[t] = y1; }
}
__device__ __forceinline__ void load16f(const float* p, float (&v)[16]) {
#pragma unroll
    for (int q = 0; q < 4; ++q) { const f32x4 t = *(const f32x4*)(p + 4 * q); v[4 * q] = t.x; v[4 * q + 1] = t.y; v[4 * q + 2] = t.z; v[4 * q + 3] = t.w; }
}
__device__ __forceinline__ void cvt_out8(const bf16* src, float* dst) { const v4u w = *(const v4u*)src; *(f32x4*)dst = (f32x4){blo(w.x), bhi(w.x), blo(w.y), bhi(w.y)}; *(f32x4*)(dst + 4) = (f32x4){blo(w.z), bhi(w.z), blo(w.w), bhi(w.w)}; }
__device__ __forceinline__ void post_touch(CArgs& a, int m, int lane, LAS unsigned char* dummy) {
    const bf16* pr = (const bf16*)(a.ws + WS_PROJ) + (size_t)m * DIN;
    if (m < MC) { const int col = lane < 32 ? A_K + lane * 64 : lane < 56 ? B_Q + (lane - 32) * 64 : D_K + (lane - 56) * 64; __builtin_amdgcn_global_load_lds((const unsigned*)(pr + col), (LAS unsigned*)dummy, 4, 0, 0); }
    else { const int col = lane < 32 ? A_Q + lane * 64 : lane < 52 ? B_Q + (lane - 32) * 64 : D_Q + (lane - 52) * 64; __builtin_amdgcn_global_load_lds((const unsigned*)(pr + col), (LAS unsigned*)dummy, 4, 0, 0);
           }
}
__device__ __forceinline__ void post_row(CArgs& a, int l, int m, int lane) {
    bf16* pr = (bf16*)(a.ws + WS_PROJ) + (size_t)m * DIN;
    const float* qg = a.in[I_QNG] + l * 128; const float* kg = a.in[I_KNG] + l * 128;
    const int hh = lane >> 3, sub = lane & 7;
    if (m < MC) {
        const int b = m >> 8, n = m & 255; const size_t r1 = ((size_t)(b * 2 + l) * 256 + n);
        float* o_ak = a.out + O_AK + r1 * 1024; float* o_av = a.out + O_AV + r1 * 1024;
#pragma unroll
        for (int j = 0; j < 2; ++j) { const int e = (lane + 64 * j) * 8; cvt_out8(pr + A_K + e, o_ak + e); cvt_out8(pr + A_V + e, o_av + e); }
        float* o_bk = a.out + O_BK + r1 * 256; float* o_bv = a.out + O_BV + r1 * 256; float* o_dk = a.out + O_DK + r1 * 256; float* o_dv = a.out + O_DV + r1 * 256;
        if (lane < 32) { const int e = lane * 8; cvt_out8(pr + B_V + e, o_bv + e); cvt_out8(pr + D_K + e, o_dk + e); cvt_out8(pr + D_V + e, o_dv + e); }
#pragma unroll
        for (int pass = 0; pass < 2; ++pass) {
            const bool act = pass == 0 || lane < 16; const int hq = pass == 0 ? hh : (hh & 1);
            bf16* hp = pr + (pass == 0 ? B_Q : B_K) + hq * 128 + sub * 16; const float* g = (pass == 0 ? qg : kg) + sub * 16;
            float x0[8], x1[8], g16[16]; unpack8(*(const v4u*)hp, x0); unpack8(*(const v4u*)(hp + 8), x1); load16f(g, g16);
            float ss = 0.f;
#pragma unroll
            for (int t = 0; t < 8; ++t) ss += x0[t] * x0[t] + x1[t] * x1[t];
            ss = red8(ss);
            const float r = 1.f / sqrtf(ss * (1.f / 128.f) + RMS_EPS);
#pragma unroll
            for (int t = 0; t < 8; ++t) { x0[t] = x0[t] * r * g16[t]; x1[t] = x1[t] * r * g16[8 + t]; }
            if (act) { *(v4u*)hp = pack8(x0); *(v4u*)(hp + 8) = pack8(x1);
                if (pass == 1) { float* ob = o_bk + hq * 128 + sub * 16; *(f32x4*)ob = (f32x4){x0[0], x0[1], x0[2], x0[3]}; *(f32x4*)(ob + 4) = (f32x4){x0[4], x0[5], x0[6], x0[7]};
                    *(f32x4*)(ob + 8) = (f32x4){x1[0], x1[1], x1[2], x1[3]}; *(f32x4*)(ob + 12) = (f32x4){x1[4], x1[5], x1[6], x1[7]}; } }
        }
    } else {
        const int n = (m - MC) & 4095, rr = n >> 6, cc = n & 63;
        { const int ha = lane >> 2, sa = lane & 3, half = sa >> 1, j = sa & 1; float cs[16]; load16f((const float*)(a.ws + WS_ROPEA) + ((half ? cc : rr) * 16 + j * 8) * 2, cs);
#pragma unroll
            for (int t2 = 0; t2 < 2; ++t2) { bf16* hp = pr + (t2 ? A_K : A_Q) + ha * 64 + half * 32 + j * 8; float x0[8], x1[8]; unpack8(*(const v4u*)hp, x0); unpack8(*(const v4u*)(hp + 16), x1);
                rope8(x0, x1, cs); *(v4u*)hp = pack8(x0); *(v4u*)(hp + 16) = pack8(x1); } }
        { const int half = sub >> 2, j = sub & 3; float cs[16]; load16f((const float*)(a.ws + WS_ROPE) + ((half ? cc : rr) * 32 + j * 8) * 2, cs);
#pragma unroll
            for (int pass = 0; pass < 3; ++pass) {
                const bool act = pass < 2 || lane < 32; const bool isB = pass == 0 || (pass == 2 && lane < 16); const int hq = pass < 2 ? hh : (hh & 1);
                bf16* hp = pr + (pass == 0 ? B_Q : pass == 1 ? D_Q : (lane < 16 ? B_K : D_K)) + hq * 128 + half * 64 + j * 8;
                const float* g = (pass == 0 ? qg : kg) + half * 64 + j * 8;
                float x0[8], x1[8]; unpack8(*(const v4u*)hp, x0); unpack8(*(const v4u*)(hp + 32), x1);
                float ss = 0.f;
#pragma unroll
                for (int t = 0; t < 8; ++t) ss += x0[t] * x0[t] + x1[t] * x1[t];
                ss = red8(ss);
                if (isB) { const float r = 1.f / sqrtf(ss * (1.f / 128.f) + RMS_EPS); const f32x4 ga = *(const f32x4*)g, gb = *(const f32x4*)(g + 4), gc = *(const f32x4*)(g + 32), gd = *(const f32x4*)(g + 36);
                    const float g0[8] = {ga.x, ga.y, ga.z, ga.w, gb.x, gb.y, gb.z, gb.w}, g1[8] = {gc.x, gc.y, gc.z, gc.w, gd.x, gd.y, gd.z, gd.w};
#pragma unroll
                    for (int t = 0; t < 8; ++t) { x0[t] = x0[t] * r * g0[t]; x1[t] = x1[t] * r * g1[t]; } }
                rope8(x0, x1, cs);
                if (act) { *(v4u*)hp = pack8(x0); *(v4u*)(hp + 32) = pack8(x1); }
            } }
    }
}
namespace fa {
using bf16x8 = __attribute__((ext_vector_type(8))) short;
using s16x4  = __attribute__((ext_vector_type(4))) short;
using f32x16 = __attribute__((ext_vector_type(16))) float;
using u32x4  = __attribute__((ext_vector_type(4))) unsigned;
typedef LAS char* lptr;
constexpr int KVBLK = 64;
constexpr int SHM_V = 64 * 128 * 2, SHM_K = 64 * 128 * 2, SHM_ATTN = 2 * SHM_V + 2 * SHM_K + 8 * 64 * 4;
constexpr float THR = 8.f;
#define FA_KSWZ(row, colB) ((row) * 256 + ((colB) ^ (((row) & 7) << 4)))
#define FA_KSWZ64(row, colB) ((row) * 128 + ((colB) ^ ((((row) >> 1) & 7) << 4)))
#define FA_SBAR() __builtin_amdgcn_sched_barrier(0)
__device__ __forceinline__ int crow(int r, int hi) { return (r & 3) + 8 * (r >> 2) + 4 * hi; }
__device__ __forceinline__ unsigned cvtpk(float lo, float hi) { unsigned r; asm volatile("v_cvt_pk_bf16_f32 %0, %1, %2" : "=v"(r) : "v"(lo), "v"(hi)); return r; }
template <int DQK> struct Sc { static constexpr float SCALE = DQK == 128 ? 0.088388347648318440f : 0.125f; };

template <int DQK>
__device__ __forceinline__ void partialSM(f32x16& p0, f32x16& p1, float& m_reg, float& mn, float& alpha) {
  constexpr float SCALE = Sc<DQK>::SCALE, C = SCALE * 1.4426950408889634f;
  float pmax = p0[0];
#pragma unroll
  for (int r = 1; r < 16; ++r) pmax = fmaxf(pmax, p0[r]);
#pragma unroll
  for (int r = 0; r < 16; ++r) pmax = fmaxf(pmax, p1[r]);
  { auto rr = __builtin_amdgcn_permlane32_swap(__float_as_uint(pmax), __float_as_uint(pmax), false, false);
    pmax = fmaxf(__uint_as_float(rr[0]), __uint_as_float(rr[1])); }
  if (__builtin_expect(__all(pmax - m_reg <= THR / SCALE), 1)) { mn = m_reg; alpha = 1.f; }
  else { mn = fmaxf(m_reg, pmax); alpha = __builtin_amdgcn_exp2f((m_reg - mn) * C); m_reg = mn; }
  const float mnC = -mn * C;
#pragma unroll
  for (int r = 0; r < 16; ++r) p0[r] = fmaf(p0[r], C, mnC);
#pragma unroll
  for (int r = 0; r < 16; ++r) p1[r] = fmaf(p1[r], C, mnC);
#pragma unroll
  for (int r = 0; r < 16; ++r) p0[r] = __builtin_amdgcn_exp2f(p0[r]);
}
__device__ __forceinline__ void finishSM(f32x16& p0, f32x16& p1, float alpha, float& l_reg, bf16x8& pa0, bf16x8& pa1, bf16x8& pa2, bf16x8& pa3) {
#pragma unroll
  for (int r = 0; r < 16; ++r) p1[r] = __builtin_amdgcn_exp2f(p1[r]);
  float ps = 0;
#pragma unroll
  for (int r = 0; r < 16; ++r) ps += p0[r];
#pragma unroll
  for (int r = 0; r < 16; ++r) ps += p1[r];
  { auto rr = __builtin_amdgcn_permlane32_swap(__float_as_uint(ps), __float_as_uint(ps), false, false);
    ps = __uint_as_float(rr[0]) + __uint_as_float(rr[1]); }
  l_reg = l_reg * alpha + ps;
#define FA_PK4(P, BASE, OUT) do { unsigned a0 = cvtpk(P[BASE + 0], P[BASE + 1]), a1 = cvtpk(P[BASE + 2], P[BASE + 3]);   \
    unsigned b0 = cvtpk(P[BASE + 4], P[BASE + 5]), b1 = cvtpk(P[BASE + 6], P[BASE + 7]);                              \
    auto r0 = __builtin_amdgcn_permlane32_swap(a0, b0, false, false); auto r1 = __builtin_amdgcn_permlane32_swap(a1, b1, false, false); \
    u32x4 w = {r0[0], r1[0], r0[1], r1[1]}; OUT = __builtin_bit_cast(bf16x8, w); } while (0)
  FA_PK4(p0, 0, pa0); FA_PK4(p0, 8, pa1); FA_PK4(p1, 0, pa2); FA_PK4(p1, 8, pa3);
#undef FA_PK4
}
template <int DQK>
__device__ __forceinline__ void qkt(f32x16& p0, f32x16& p1, lptr Ks, const bf16x8* qr, int r32, int hi) {
  p0 = f32x16{}; p1 = f32x16{};
#pragma unroll
  for (int d0 = 0; d0 < DQK / 16; ++d0) { const int cb = (d0 * 16 + hi * 8) * 2;
    const bf16x8 b0 = *(const LAS bf16x8*)(Ks + (DQK == 128 ? FA_KSWZ(r32, cb) : FA_KSWZ64(r32, cb)));
    const bf16x8 b1 = *(const LAS bf16x8*)(Ks + (DQK == 128 ? FA_KSWZ(32 + r32, cb) : FA_KSWZ64(32 + r32, cb)));
    p0 = __builtin_amdgcn_mfma_f32_32x32x16_bf16(b0, qr[d0], p0, 0, 0, 0);
    p1 = __builtin_amdgcn_mfma_f32_32x32x16_bf16(b1, qr[d0], p1, 0, 0, 0); }
}
__device__ __forceinline__ void band_mask(f32x16& p0, f32x16& p1, int kpos0, int qpos, int hi) {
#pragma unroll
  for (int r = 0; r < 16; ++r) { const int d0 = kpos0 + crow(r, hi) - qpos, d1 = d0 + 32;
    p0[r] = (d0 > 128 || d0 < -128) ? -1e30f : p0[r]; p1[r] = (d1 > 128 || d1 < -128) ? -1e30f : p1[r]; }
}
__device__ __forceinline__ int v_st(int k, int c) { const int kk = (k & ~0xC) | ((k & 4) << 1) | ((k & 8) >> 1); return ((kk >> 3) * 4 + (c >> 5)) * 512 + ((kk & 7) * 32 + (c & 31)) * 2; }
__device__ __forceinline__ int v_rd_base(int lane) { return ((lane & 3) << 3) | (((lane >> 2) & 3) << 6) | (((lane >> 4) & 1) << 5) | (((lane >> 5) & 1) << 8); }
constexpr int v_rd_off(int d0, int ks, int half) { return d0 * 512 + ks * 4096 + half * 2048; }
template <int OFF> __device__ __forceinline__ s16x4 tr_read(int vb) {
  s16x4 r; asm volatile("ds_read_b64_tr_b16 %0, %1 offset:%2" : "=&v"(r) : "v"(vb), "i"(OFF) : "memory"); return r;
}
template <int D0> __device__ __forceinline__ void pv_one(f32x16& od, int vb, bf16x8 pa0, bf16x8 pa1, bf16x8 pa2, bf16x8 pa3) {
  const s16x4 l0 = tr_read<v_rd_off(D0, 0, 0)>(vb), h0 = tr_read<v_rd_off(D0, 0, 1)>(vb), l1 = tr_read<v_rd_off(D0, 1, 0)>(vb), h1 = tr_read<v_rd_off(D0, 1, 1)>(vb);
  const s16x4 l2 = tr_read<v_rd_off(D0, 2, 0)>(vb), h2 = tr_read<v_rd_off(D0, 2, 1)>(vb), l3 = tr_read<v_rd_off(D0, 3, 0)>(vb), h3 = tr_read<v_rd_off(D0, 3, 1)>(vb);
  asm volatile("s_waitcnt lgkmcnt(0)" ::: "memory"); FA_SBAR();
#define FA_PK(L, H) (bf16x8){L[0], L[1], L[2], L[3], H[0], H[1], H[2], H[3]}
  od = __builtin_amdgcn_mfma_f32_32x32x16_bf16(pa0, FA_PK(l0, h0), od, 0, 0, 0);
  od = __builtin_amdgcn_mfma_f32_32x32x16_bf16(pa1, FA_PK(l1, h1), od, 0, 0, 0);
  od = __builtin_amdgcn_mfma_f32_32x32x16_bf16(pa2, FA_PK(l2, h2), od, 0, 0, 0);
  od = __builtin_amdgcn_mfma_f32_32x32x16_bf16(pa3, FA_PK(l3, h3), od, 0, 0, 0);
#undef FA_PK
}
template <int DA, int DB> __device__ __forceinline__ void pv_two(f32x16& oa, f32x16& ob, int vb, bf16x8 pa0, bf16x8 pa1, bf16x8 pa2, bf16x8 pa3) {
  const s16x4 al0 = tr_read<v_rd_off(DA, 0, 0)>(vb), ah0 = tr_read<v_rd_off(DA, 0, 1)>(vb), bl0 = tr_read<v_rd_off(DB, 0, 0)>(vb), bh0 = tr_read<v_rd_off(DB, 0, 1)>(vb);
  const s16x4 al1 = tr_read<v_rd_off(DA, 1, 0)>(vb), ah1 = tr_read<v_rd_off(DA, 1, 1)>(vb), bl1 = tr_read<v_rd_off(DB, 1, 0)>(vb), bh1 = tr_read<v_rd_off(DB, 1, 1)>(vb);
  const s16x4 al2 = tr_read<v_rd_off(DA, 2, 0)>(vb), ah2 = tr_read<v_rd_off(DA, 2, 1)>(vb), bl2 = tr_read<v_rd_off(DB, 2, 0)>(vb), bh2 = tr_read<v_rd_off(DB, 2, 1)>(vb);
  const s16x4 al3 = tr_read<v_rd_off(DA, 3, 0)>(vb), ah3 = tr_read<v_rd_off(DA, 3, 1)>(vb), bl3 = tr_read<v_rd_off(DB, 3, 0)>(vb), bh3 = tr_read<v_rd_off(DB, 3, 1)>(vb);
  asm volatile("s_waitcnt lgkmcnt(0)" ::: "memory"); FA_SBAR();
#define FA_PK(L, H) (bf16x8){L[0], L[1], L[2], L[3], H[0], H[1], H[2], H[3]}
  oa = __builtin_amdgcn_mfma_f32_32x32x16_bf16(pa0, FA_PK(al0, ah0), oa, 0, 0, 0); ob = __builtin_amdgcn_mfma_f32_32x32x16_bf16(pa0, FA_PK(bl0, bh0), ob, 0, 0, 0);
  oa = __builtin_amdgcn_mfma_f32_32x32x16_bf16(pa1, FA_PK(al1, ah1), oa, 0, 0, 0); ob = __builtin_amdgcn_mfma_f32_32x32x16_bf16(pa1, FA_PK(bl1, bh1), ob, 0, 0, 0);
  oa = __builtin_amdgcn_mfma_f32_32x32x16_bf16(pa2, FA_PK(al2, ah2), oa, 0, 0, 0); ob = __builtin_amdgcn_mfma_f32_32x32x16_bf16(pa2, FA_PK(bl2, bh2), ob, 0, 0, 0);
  oa = __builtin_amdgcn_mfma_f32_32x32x16_bf16(pa3, FA_PK(al3, ah3), oa, 0, 0, 0); ob = __builtin_amdgcn_mfma_f32_32x32x16_bf16(pa3, FA_PK(bl3, bh3), ob, 0, 0, 0);
#undef FA_PK
}
__device__ __forceinline__ void pv_d0(f32x16* o, int vb, bf16x8 pa0, bf16x8 pa1, bf16x8 pa2, bf16x8 pa3) {
  pv_two<0, 1>(o[0], o[1], vb, pa0, pa1, pa2, pa3); pv_two<2, 3>(o[2], o[3], vb, pa0, pa1, pa2, pa3);
}

struct Src { const bf16* K; const bf16* V; int ld; };
template <int DQK, bool BAND>
__device__ __forceinline__ void core(const bf16* __restrict__ Qb, int ldq, const Src A, int NTA, const Src B, int NT, int q0, int kb0, lptr lds, f32x16 (&o)[4], float& m_out, float& l_out, int wv) {
  int tid = tid_of(wv); asm volatile("" : "+v"(tid));
  const int wid = tid >> 6, lane = tid & 63, r32 = lane & 31, hi = lane >> 5;
  lptr V_lds = lds; lptr K_lds = lds + 2 * SHM_V;
  LAS float* al_l = (LAS float*)(lds + 2 * SHM_V + 2 * SHM_K) + wid * 64 + 32;
  float m_reg = -1e30f, l_reg = 0.f;
#pragma unroll
  for (int d = 0; d < 4; ++d) o[d] = f32x16{};
  bf16x8 qr[DQK / 16];
  { const bf16* Qw = Qb + (size_t)(wid * 32 + r32) * ldq + hi * 8;
#pragma unroll
    for (int d0 = 0; d0 < DQK / 16; ++d0) qr[d0] = *(const bf16x8*)(Qw + d0 * 16); }
  const int qpos = q0 + wid * 32 + r32, qmin = q0 + wid * 32;
  const int sr = tid >> 4, sc = (tid & 15) * 8, vst0 = v_st(sr, sc), vst1 = v_st(32 + sr, sc);
  const int k64r = tid >> 3, k64c = (tid & 7) * 8;
  const int vb0 = (int)(uintptr_t)V_lds + v_rd_base(lane);
  struct { bf16x8 vs0, vs1, ks0, ks1; } st[2];
#define FA_SLOAD(i, t) do { const bool inA_ = (t) < NTA; const bf16* Kp_ = inA_ ? A.K : B.K; const bf16* Vp_ = inA_ ? A.V : B.V; const int ld_ = inA_ ? A.ld : B.ld; const int k0_ = (inA_ ? (t) : (t) - NTA) * KVBLK; \
    st[i].vs0 = *(const bf16x8*)(Vp_ + (size_t)(k0_ + sr) * ld_ + sc); st[i].vs1 = *(const bf16x8*)(Vp_ + (size_t)(k0_ + 32 + sr) * ld_ + sc); \
    if constexpr (DQK == 128) { st[i].ks0 = *(const bf16x8*)(Kp_ + (size_t)(k0_ + sr) * ld_ + sc); st[i].ks1 = *(const bf16x8*)(Kp_ + (size_t)(k0_ + 32 + sr) * ld_ + sc); } \
    else { st[i].ks0 = *(const bf16x8*)(Kp_ + (size_t)(k0_ + k64r) * ld_ + k64c); } } while (0)
#define FA_SWRITE(b, i) do { *(LAS bf16x8*)(V_lds + (b) * SHM_V + vst0) = st[i].vs0; *(LAS bf16x8*)(V_lds + (b) * SHM_V + vst1) = st[i].vs1; \
    if constexpr (DQK == 128) { const int kc = sc * 2; *(LAS bf16x8*)(K_lds + (b) * SHM_K + FA_KSWZ(sr, kc)) = st[i].ks0; *(LAS bf16x8*)(K_lds + (b) * SHM_K + FA_KSWZ(32 + sr, kc)) = st[i].ks1; } \
    else { *(LAS bf16x8*)(K_lds + (b) * SHM_K + FA_KSWZ64(k64r, k64c * 2)) = st[i].ks0; } } while (0)
#define FA_SWAIT() do { if constexpr (DQK == 128) asm volatile("s_waitcnt vmcnt(4)" ::: "memory"); else asm volatile("s_waitcnt vmcnt(3)" ::: "memory"); } while (0)
#define FA_RESC(a) do { if (__any((a) < 1.f)) { if (hi == 0) al_l[r32] = (a); asm volatile("s_waitcnt lgkmcnt(0)" ::: "memory"); \
    _Pragma("unroll") for (int d = 0; d < 4; ++d) _Pragma("unroll") for (int r = 0; r < 16; ++r) o[d][r] *= al_l[crow(r, hi)]; } } while (0)
#define FA_MASK(P0, P1, t) do { if constexpr (BAND) { if ((t) >= NTA) { const int kp0_ = kb0 + ((t) - NTA) * KVBLK; \
    if (!(kp0_ >= qmin + 31 - 128 && kp0_ + 63 <= qmin + 128)) band_mask(P0, P1, kp0_, qpos, hi); } } } while (0)
  f32x16 pA0, pA1, pB0, pB1; float mnA, mnB, alA, alB; bf16x8 pa0, pa1, pa2, pa3;
  FA_SLOAD(0, 0); FA_SLOAD(1, 1);
  FA_SWAIT(); FA_SWRITE(0, 0); __syncthreads();
  if (2 < NT) FA_SLOAD(0, 2);
  qkt<DQK>(pA0, pA1, K_lds, qr, r32, hi); FA_MASK(pA0, pA1, 0); partialSM<DQK>(pA0, pA1, m_reg, mnA, alA);
  FA_SWAIT(); FA_SWRITE(1, 1); __syncthreads();
  for (int j = 1; j + 1 < NT; j += 2) {
    FA_SBAR(); qkt<DQK>(pB0, pB1, K_lds + SHM_K, qr, r32, hi);
    finishSM(pA0, pA1, alA, l_reg, pa0, pa1, pa2, pa3); FA_SBAR();
    FA_SLOAD(1, j + 2); FA_SBAR();
    pv_d0(o, vb0, pa0, pa1, pa2, pa3); FA_MASK(pB0, pB1, j); partialSM<DQK>(pB0, pB1, m_reg, mnB, alB);
    __syncthreads(); FA_SWAIT(); FA_SWRITE(0, 0);
    FA_RESC(alB); __syncthreads();
    FA_SBAR(); qkt<DQK>(pA0, pA1, K_lds, qr, r32, hi);
    finishSM(pB0, pB1, alB, l_reg, pa0, pa1, pa2, pa3); FA_SBAR();
    if (j + 3 < NT) FA_SLOAD(0, j + 3); FA_SBAR();
    pv_d0(o, vb0 + SHM_V, pa0, pa1, pa2, pa3); FA_MASK(pA0, pA1, j + 1); partialSM<DQK>(pA0, pA1, m_reg, mnA, alA);
    __syncthreads(); FA_SWAIT(); FA_SWRITE(1, 1);
    FA_RESC(alA); __syncthreads();
  }
  FA_SBAR(); qkt<DQK>(pB0, pB1, K_lds + SHM_K, qr, r32, hi);
  finishSM(pA0, pA1, alA, l_reg, pa0, pa1, pa2, pa3); FA_SBAR();
  pv_d0(o, vb0, pa0, pa1, pa2, pa3); FA_MASK(pB0, pB1, NT - 1); partialSM<DQK>(pB0, pB1, m_reg, mnB, alB);
  __syncthreads(); FA_RESC(alB);
  finishSM(pB0, pB1, alB, l_reg, pa0, pa1, pa2, pa3); FA_SBAR();
  pv_d0(o, vb0 + SHM_V, pa0, pa1, pa2, pa3);
  m_out = m_reg; l_out = l_reg;
#undef FA_SLOAD
#undef FA_SWRITE
#undef FA_SWAIT
#undef FA_RESC
#undef FA_MASK
}
constexpr int CTX_SCR = 131072 + 1024;
template <int DQK, bool BAND>
__device__ __forceinline__ void core3(const bf16* __restrict__ Qb, int ldq, const Src A, int NTA, const Src B, int NT, int q0, int kb0, lptr lds, f32x16 (&o)[4], float& m_out, float& l_out, int wv) {
  int tid = tid_of(wv); asm volatile("" : "+v"(tid));
  const int wid = tid >> 6, lane = tid & 63, r32 = lane & 31, hi = lane >> 5;
  lptr V_lds = lds; lptr K_lds = lds + 3 * SHM_V;
  LAS float* al_l = (LAS float*)(lds + CTX_SCR) + wid * 64 + 32;
  float m_reg = -1e30f, l_reg = 0.f;
#pragma unroll
  for (int d = 0; d < 4; ++d) o[d] = f32x16{};
  bf16x8 qr[DQK / 16];
  { const bf16* Qw = Qb + (size_t)(wid * 32 + r32) * ldq + hi * 8;
#pragma unroll
    for (int d0 = 0; d0 < DQK / 16; ++d0) qr[d0] = *(const bf16x8*)(Qw + d0 * 16); }
  const int qpos = q0 + wid * 32 + r32, qmin = q0 + wid * 32;
  const int sr = tid >> 4, sc = (tid & 15) * 8, vst0 = v_st(sr, sc), vst1 = v_st(32 + sr, sc);
  const int k64r = tid >> 3, k64c = (tid & 7) * 8;
  const int vb0 = (int)(uintptr_t)V_lds + v_rd_base(lane);
  struct { bf16x8 vs0, vs1, ks0, ks1; } st[2];
#define C3_SLOAD(i, t) do { const bool inA_ = (t) < NTA; const bf16* Kp_ = inA_ ? A.K : B.K; const bf16* Vp_ = inA_ ? A.V : B.V; const int ld_ = inA_ ? A.ld : B.ld; const int k0_ = (inA_ ? (t) : (t) - NTA) * KVBLK; \
    st[i].vs0 = *(const bf16x8*)(Vp_ + (size_t)(k0_ + sr) * ld_ + sc); st[i].vs1 = *(const bf16x8*)(Vp_ + (size_t)(k0_ + 32 + sr) * ld_ + sc); \
    if constexpr (DQK == 128) { st[i].ks0 = *(const bf16x8*)(Kp_ + (size_t)(k0_ + sr) * ld_ + sc); st[i].ks1 = *(const bf16x8*)(Kp_ + (size_t)(k0_ + 32 + sr) * ld_ + sc); } \
    else { st[i].ks0 = *(const bf16x8*)(Kp_ + (size_t)(k0_ + k64r) * ld_ + k64c); } } while (0)
#define C3_SWRITE(b, i) do { *(LAS bf16x8*)(V_lds + (b) * SHM_V + vst0) = st[i].vs0; *(LAS bf16x8*)(V_lds + (b) * SHM_V + vst1) = st[i].vs1; \
    if constexpr (DQK == 128) { const int kc = sc * 2; *(LAS bf16x8*)(K_lds + (b) * SHM_K + FA_KSWZ(sr, kc)) = st[i].ks0; *(LAS bf16x8*)(K_lds + (b) * SHM_K + FA_KSWZ(32 + sr, kc)) = st[i].ks1; } \
    else { *(LAS bf16x8*)(K_lds + (b) * SHM_K + FA_KSWZ64(k64r, k64c * 2)) = st[i].ks0; } } while (0)
#define C3_SWAIT() do { if constexpr (DQK == 128) asm volatile("s_waitcnt vmcnt(4)" ::: "memory"); else asm volatile("s_waitcnt vmcnt(3)" ::: "memory"); } while (0)
#define C3_RESC(a) do { if (__any((a) < 1.f)) { if (hi == 0) al_l[r32] = (a); asm volatile("s_waitcnt lgkmcnt(0)" ::: "memory"); \
    _Pragma("unroll") for (int d = 0; d < 4; ++d) _Pragma("unroll") for (int r = 0; r < 16; ++r) o[d][r] *= al_l[crow(r, hi)]; } } while (0)
#define C3_MASK(P0, P1, t) do { if constexpr (BAND) { if ((t) >= NTA) { const int kp0_ = kb0 + ((t) - NTA) * KVBLK; \
    if (!(kp0_ >= qmin + 31 - 128 && kp0_ + 63 <= qmin + 128)) band_mask(P0, P1, kp0_, qpos, hi); } } } while (0)
#define C3_ITER(t, PX0, PX1, mnX, alX, PY0, PY1, alY) do { \
    FA_SBAR(); qkt<DQK>(PX0, PX1, K_lds + bt * SHM_K, qr, r32, hi); finishSM(PY0, PY1, alY, l_reg, pa0, pa1, pa2, pa3); FA_SBAR(); \
    if ((t) + 2 < NT) { if ((t) & 1) C3_SLOAD(1, (t) + 2); else C3_SLOAD(0, (t) + 2); } FA_SBAR(); \
    pv_d0(o, vb0 + bp * SHM_V, pa0, pa1, pa2, pa3); C3_MASK(PX0, PX1, (t)); partialSM<DQK>(PX0, PX1, m_reg, mnX, alX); \
    if ((t) + 1 < NT) { C3_SWAIT(); if ((t) & 1) C3_SWRITE(bn, 0); else C3_SWRITE(bn, 1); } \
    C3_RESC(alX); \
    bp = bt; bt = bn; bn = bn == 2 ? 0 : bn + 1; } while (0)
  f32x16 pA0, pA1, pB0, pB1; float mnA, mnB, alA, alB; bf16x8 pa0, pa1, pa2, pa3;
  C3_SLOAD(0, 0); C3_SLOAD(1, 1);
  C3_SWAIT(); C3_SWRITE(0, 0); __syncthreads();
  if (2 < NT) C3_SLOAD(0, 2);
  qkt<DQK>(pA0, pA1, K_lds, qr, r32, hi); C3_MASK(pA0, pA1, 0); partialSM<DQK>(pA0, pA1, m_reg, mnA, alA);
  C3_SWAIT(); C3_SWRITE(1, 1); __syncthreads();
  int bt = 1, bp = 0, bn = 2;
  for (int t = 1; t + 2 < NT; t += 2) {
    C3_ITER(t, pB0, pB1, mnB, alB, pA0, pA1, alA); __syncthreads();
    C3_ITER(t + 1, pA0, pA1, mnA, alA, pB0, pB1, alB); __syncthreads();
  }
  C3_ITER(NT - 1, pB0, pB1, mnB, alB, pA0, pA1, alA);
  finishSM(pB0, pB1, alB, l_reg, pa0, pa1, pa2, pa3); FA_SBAR();
  pv_d0(o, vb0 + bp * SHM_V, pa0, pa1, pa2, pa3);
  m_out = m_reg; l_out = l_reg;
#undef C3_SLOAD
#undef C3_SWRITE
#undef C3_SWAIT
#undef C3_RESC
#undef C3_MASK
#undef C3_ITER
}
template <int DQK>
__device__ __forceinline__ void core_ctx(const bf16* __restrict__ Qb, int ldq, const Src A, lptr lds, f32x16 (&o)[4], float& m_out, float& l_out, int wv) {
  int tid = tid_of(wv); asm volatile("" : "+v"(tid));
  const int wid = tid >> 6, lane = tid & 63, r32 = lane & 31, hi = lane >> 5;
  lptr V_lds = lds; lptr K_lds = lds + 4 * SHM_V;
  LAS float* al_l = (LAS float*)(lds + CTX_SCR) + wid * 64 + 32;
  float m_reg = -1e30f, l_reg = 0.f;
  bf16x8 qr[DQK / 16];
  { const bf16* Qw = Qb + (size_t)(wid * 32 + r32) * ldq + hi * 8;
#pragma unroll
    for (int d0 = 0; d0 < DQK / 16; ++d0) qr[d0] = *(const bf16x8*)(Qw + d0 * 16); }
  { const int sr = tid >> 4, sc = (tid & 15) * 8, vst0 = v_st(sr, sc), vst1 = v_st(32 + sr, sc); const int k64r = tid >> 3, k64c = (tid & 7) * 8;
    bf16x8 vs[4][2], ks[4][2];
#pragma unroll
    for (int t = 0; t < 4; ++t) { vs[t][0] = *(const bf16x8*)(A.V + (size_t)(t * 64 + sr) * A.ld + sc); vs[t][1] = *(const bf16x8*)(A.V + (size_t)(t * 64 + 32 + sr) * A.ld + sc);
      if constexpr (DQK == 128) { ks[t][0] = *(const bf16x8*)(A.K + (size_t)(t * 64 + sr) * A.ld + sc); ks[t][1] = *(const bf16x8*)(A.K + (size_t)(t * 64 + 32 + sr) * A.ld + sc); }
      else ks[t][0] = *(const bf16x8*)(A.K + (size_t)(t * 64 + k64r) * A.ld + k64c); }
#pragma unroll
    for (int t = 0; t < 4; ++t) { *(LAS bf16x8*)(V_lds + t * SHM_V + vst0) = vs[t][0]; *(LAS bf16x8*)(V_lds + t * SHM_V + vst1) = vs[t][1];
      if constexpr (DQK == 128) { *(LAS bf16x8*)(K_lds + t * SHM_K + FA_KSWZ(sr, sc * 2)) = ks[t][0]; *(LAS bf16x8*)(K_lds + t * SHM_K + FA_KSWZ(32 + sr, sc * 2)) = ks[t][1]; }
      else *(LAS bf16x8*)(K_lds + t * SHM_K + FA_KSWZ64(k64r, k64c * 2)) = ks[t][0]; } }
  __syncthreads();
#pragma unroll
  for (int d = 0; d < 4; ++d) o[d] = f32x16{};
  const int vb0 = (int)(uintptr_t)V_lds + v_rd_base(lane);
#define FA_RESC(a) do { if (__any((a) < 1.f)) { if (hi == 0) al_l[r32] = (a); asm volatile("s_waitcnt lgkmcnt(0)" ::: "memory"); \
    _Pragma("unroll") for (int d = 0; d < 4; ++d) _Pragma("unroll") for (int r = 0; r < 16; ++r) o[d][r] *= al_l[crow(r, hi)]; } } while (0)
  f32x16 pA0, pA1, pB0, pB1; float mnA, mnB, alA, alB; bf16x8 pa0, pa1, pa2, pa3;
  qkt<DQK>(pA0, pA1, K_lds, qr, r32, hi); partialSM<DQK>(pA0, pA1, m_reg, mnA, alA);
  FA_SBAR(); qkt<DQK>(pB0, pB1, K_lds + SHM_K, qr, r32, hi); finishSM(pA0, pA1, alA, l_reg, pa0, pa1, pa2, pa3); FA_SBAR();
  pv_d0(o, vb0, pa0, pa1, pa2, pa3); partialSM<DQK>(pB0, pB1, m_reg, mnB, alB); FA_RESC(alB);
  FA_SBAR(); qkt<DQK>(pA0, pA1, K_lds + 2 * SHM_K, qr, r32, hi); finishSM(pB0, pB1, alB, l_reg, pa0, pa1, pa2, pa3); FA_SBAR();
  pv_d0(o, vb0 + SHM_V, pa0, pa1, pa2, pa3); partialSM<DQK>(pA0, pA1, m_reg, mnA, alA); FA_RESC(alA);
  FA_SBAR(); qkt<DQK>(pB0, pB1, K_lds + 3 * SHM_K, qr, r32, hi); finishSM(pA0, pA1, alA, l_reg, pa0, pa1, pa2, pa3); FA_SBAR();
  pv_d0(o, vb0 + 2 * SHM_V, pa0, pa1, pa2, pa3); partialSM<DQK>(pB0, pB1, m_reg, mnB, alB); FA_RESC(alB);
  finishSM(pB0, pB1, alB, l_reg, pa0, pa1, pa2, pa3); FA_SBAR();
  pv_d0(o, vb0 + 3 * SHM_V, pa0, pa1, pa2, pa3);
  m_out = m_reg; l_out = l_reg;
#undef FA_RESC
}
__device__ __forceinline__ void row_bcast(float lv, lptr scratch, int wid, int r32, int hi, float (&f)[16]) {
  LAS float* li_l = (LAS float*)scratch + wid * 64;
  if (hi == 0) li_l[r32] = lv; asm volatile("s_waitcnt lgkmcnt(0)" ::: "memory");
#pragma unroll
  for (int r = 0; r < 16; ++r) f[r] = li_l[crow(r, hi)];
  asm volatile("s_waitcnt lgkmcnt(0)" ::: "memory");
}
constexpr int TILE_STRIDE = 272, TILE_BYTES = 32 * TILE_STRIDE;
__device__ __forceinline__ void tile_put(lptr tile, int r32, int hi, const f32x16 (&o)[4], const float (&sc)[16]) {
#pragma unroll
  for (int rr = 0; rr < 16; ++rr) { const int row = crow(rr, hi);
#pragma unroll
    for (int d0 = 0; d0 < 4; d0 += 2) { const unsigned w = pk2(o[d0][rr] * sc[rr], o[d0 + 1][rr] * sc[rr]);
      *(LAS bf16*)(tile + row * TILE_STRIDE + (d0 * 32 + r32) * 2) = (bf16)(w & 0xffffu); *(LAS bf16*)(tile + row * TILE_STRIDE + ((d0 + 1) * 32 + r32) * 2) = (bf16)(w >> 16); } }
}
__device__ __forceinline__ void tile_gates(int lane, const bf16* gate_rows, v4u (&gq)[8]) {
#pragma unroll
  for (int it = 0; it < 8; ++it) { const int c = it * 64 + lane, row = c >> 4, cc = (c & 15) * 8; gq[it] = *(const v4u*)(gate_rows + (size_t)row * DIN + cc); }
}
__device__ __forceinline__ void tile_emit(lptr tile, int lane, const v4u (&gq)[8], bf16* mix_rows, const float* colscale) {
#pragma unroll
  for (int it = 0; it < 8; ++it) { const int c = it * 64 + lane, row = c >> 4, cc = (c & 15) * 8;
    const v4u tv = *(const LAS v4u*)(tile + row * TILE_STRIDE + cc * 2); const v4u gv = gq[it];
    float x[8] = {blo(tv.x), bhi(tv.x), blo(tv.y), bhi(tv.y), blo(tv.z), bhi(tv.z), blo(tv.w), bhi(tv.w)};
    const float g[8] = {blo(gv.x), bhi(gv.x), blo(gv.y), bhi(gv.y), blo(gv.z), bhi(gv.z), blo(gv.w), bhi(gv.w)};
    if (colscale) { const f32x4 s0 = *(const f32x4*)(colscale + cc), s1 = *(const f32x4*)(colscale + cc + 4); x[0] *= s0.x; x[1] *= s0.y; x[2] *= s0.z; x[3] *= s0.w; x[4] *= s1.x; x[5] *= s1.y; x[6] *= s1.z; x[7] *= s1.w; }
#pragma unroll
    for (int t = 0; t < 8; ++t) x[t] *= siluf(g[t]);
    v4u w; w.x = pk2(x[0], x[1]); w.y = pk2(x[2], x[3]); w.z = pk2(x[4], x[5]); w.w = pk2(x[6], x[7]);
    *(v4u*)(mix_rows + (size_t)row * DM + cc) = w; }
}
}

template <int BR, bool LAT>
__device__ __forceinline__ void attn_fast_unit(CArgs& a, int l, int r, LAS unsigned char* lds_u, int wv) {
  fa::lptr lds = (fa::lptr)lds_u;
  const int b = LAT ? r >> 7 : r >> 3, h = LAT ? (r >> 4) & 7 : r & 7, qb = LAT ? r & 15 : 0, kv = h >> 2;
  const int rowbase = LAT ? MC + b * LSEQ : b * SEQ, q0 = qb * 256;
  const bf16* proj = (const bf16*)(a.ws + WS_PROJ); const bf16* pk = proj + (size_t)rowbase * DIN; const bf16* pq = pk + (size_t)q0 * DIN;
  fa::f32x16 o[4]; float mreg, lreg; float f[16];
  constexpr int NTL = LAT ? LSEQ / 64 : SEQ / 64, NTC = LAT ? 4 : 0;
#define FA_IDS() int tid_ = tid_of(wv); asm volatile("" : "+v"(tid_)); const int wid = tid_ >> 6, lane = tid_ & 63, r32 = lane & 31, hi = lane >> 5; (void)lane; \
  bf16* mix = (bf16*)(a.ws + WS_HM) + (size_t)(rowbase + q0 + wid * 32) * DM; const bf16* gate = pq + (size_t)(wid * 32) * DIN; (void)mix; (void)gate
  if constexpr (BR == 1) {
    const fa::Src S1{pk + B_K + kv * 128, pk + B_V + kv * 128, DIN};
    const fa::Src S2{(const bf16*)(a.ws + WS_CBK) + (size_t)(b * 2 + l) * 65536 + kv * 128, (const bf16*)(a.ws + WS_CBV) + (size_t)(b * 2 + l) * 65536 + kv * 128, 256};
    if constexpr (LAT) fa::core3<128, false>(pq + B_Q + h * 128, DIN, S1, NTL, S2, NTL + NTC, 0, 0, lds, o, mreg, lreg, wv); else fa::core_ctx<128>(pq + B_Q + h * 128, DIN, S1, lds, o, mreg, lreg, wv);
    FA_IDS();
    v4u gq[8]; fa::tile_gates(lane, gate + B_G + h * 128, gq);
    __syncthreads();
    fa::row_bcast(lreg, lds + fa::CTX_SCR, wid, r32, hi, f);
#pragma unroll
    for (int rr = 0; rr < 16; ++rr) f[rr] = __builtin_amdgcn_rcpf(f[rr]);
    fa::tile_put(lds + wid * fa::TILE_BYTES, r32, hi, o, f); __builtin_amdgcn_wave_barrier();
    fa::tile_emit(lds + wid * fa::TILE_BYTES, lane, gq, mix + 1024 + h * 128, nullptr);
  } else if constexpr (BR == 2) {
    const fa::Src SL{pk + D_K + kv * 128, pk + D_V + kv * 128, DIN};
    const fa::Src SC{(const bf16*)(a.ws + WS_CDK) + (size_t)(b * 2 + l) * 65536 + kv * 128, (const bf16*)(a.ws + WS_CDV) + (size_t)(b * 2 + l) * 65536 + kv * 128, 256};
    if constexpr (LAT) {
      const int kb = q0 - 128 < 0 ? 0 : q0 - 128, ke = q0 + 384 > LSEQ ? LSEQ : q0 + 384;
      const fa::Src SLb{SL.K + (size_t)kb * DIN, SL.V + (size_t)kb * DIN, DIN};
      fa::core3<128, true>(pq + D_Q + h * 128, DIN, SC, 4, SLb, 4 + (ke - kb) / 64, q0, kb, lds, o, mreg, lreg, wv);
    } else fa::core_ctx<128>(pq + D_Q + h * 128, DIN, SL, lds, o, mreg, lreg, wv);
    { const float sink = a.in[I_SINK][l * 8 + h]; lreg += __builtin_amdgcn_exp2f(sink * 1.4426950408889634f - mreg * (0.088388347648318440f * 1.4426950408889634f)); }
    FA_IDS();
    v4u gq[8]; fa::tile_gates(lane, gate + D_G + h * 128, gq);
    __syncthreads();
    fa::row_bcast(lreg, lds + fa::CTX_SCR, wid, r32, hi, f);
#pragma unroll
    for (int rr = 0; rr < 16; ++rr) f[rr] = __builtin_amdgcn_rcpf(f[rr]);
    fa::tile_put(lds + wid * fa::TILE_BYTES, r32, hi, o, f); __builtin_amdgcn_wave_barrier();
    fa::tile_emit(lds + wid * fa::TILE_BYTES, lane, gq, mix + 3072 + h * 128, nullptr);
  } else {
    const bf16* ck = (const bf16*)(a.ws + WS_CAK) + (size_t)(b * 2 + l) * 262144 + h * 128; const bf16* cv = (const bf16*)(a.ws + WS_CAV) + (size_t)(b * 2 + l) * 262144 + h * 128;
    { const fa::Src S1{pk + A_K + h * 128, pk + A_V + h * 128, DIN}; const fa::Src S2{ck, cv, 1024};
      if constexpr (LAT) fa::core3<64, false>(pq + A_Q + h * 128, DIN, S1, NTL, S2, NTL + NTC, 0, 0, lds, o, mreg, lreg, wv); else { fa::core_ctx<64>(pq + A_Q + h * 128, DIN, S1, lds, o, mreg, lreg, wv); } }
    { FA_IDS();
      fa::row_bcast(lreg, lds + fa::CTX_SCR, wid, r32, hi, f);
      float* scr = (float*)(a.ws + WS_ASCR) + ((size_t)blockIdx.x * 8 + wid) * 4096 + lane;
#pragma unroll
      for (int rr = 0; rr < 16; ++rr) { const float il = __builtin_amdgcn_rcpf(f[rr]);
#pragma unroll
        for (int d0 = 0; d0 < 4; ++d0) scr[(d0 * 16 + rr) * 64] = o[d0][rr] * il; } }
    { const fa::Src S1{pk + A_K + h * 128 + 64, pk + A_V + h * 128, DIN}; const fa::Src S2{ck + 64, cv, 1024};
      if constexpr (LAT) { __syncthreads(); fa::core3<64, false>(pq + A_Q + h * 128 + 64, DIN, S1, NTL, S2, NTL + NTC, 0, 0, lds, o, mreg, lreg, wv); } else { __syncthreads(); fa::core_ctx<64>(pq + A_Q + h * 128 + 64, DIN, S1, lds, o, mreg, lreg, wv); } }
    FA_IDS();
    fa::row_bcast(lreg, lds + fa::CTX_SCR, wid, r32, hi, f);
    const float* scr = (const float*)(a.ws + WS_ASCR) + ((size_t)blockIdx.x * 8 + wid) * 4096 + lane;
    const float lam = ((const float*)(a.ws + WS_LAM))[l], lam_init = l == 0 ? 0.2f : 0.35550906759f;
#pragma unroll
    for (int rr = 0; rr < 16; ++rr) { const float il = lam * __builtin_amdgcn_rcpf(f[rr]); float s = 0.f;
#pragma unroll
      for (int d0 = 0; d0 < 4; ++d0) { const float w = scr[(d0 * 16 + rr) * 64] - o[d0][rr] * il; o[d0][rr] = w; s += w * w; }
      s = red32(s);
      f[rr] = (1.f - lam_init) / sqrtf(s * (1.f / 128.f) + RMS_EPS); }
    __syncthreads();
    v4u gq[8]; fa::tile_gates(lane, gate + A_G + h * 128, gq);
    fa::tile_put(lds + wid * fa::TILE_BYTES, r32, hi, o, f); __builtin_amdgcn_wave_barrier();
    fa::tile_emit(lds + wid * fa::TILE_BYTES, lane, gq, mix + h * 128, a.in[I_SUBG] + l * 128);
  }
#undef FA_IDS
  __syncthreads();
}
namespace s5 {
using bf16x8 = __attribute__((ext_vector_type(8))) short;
using f32x16 = __attribute__((ext_vector_type(16))) float;
typedef LAS char* lptr;
constexpr int H_STRIDE = 288, SEQ_LDS = 16 * H_STRIDE, WAVE_LDS = 2 * SEQ_LDS, SEG_OFF = 8 * WAVE_LDS;
struct Par { bf16x8 bbh[4], cm[4]; float ar0, ai0, ar1, ai1; };
__device__ __forceinline__ void load_par(CArgs& a, int l, int d, int g, int lane, Par& P) {
    const int col = lane & 31, h = lane >> 5, c15 = lane & 15, kg = lane >> 4;
    const float* sa = (const float*)(a.ws + WS_S5A); const float* sbb = (const float*)(a.ws + WS_S5BB);
    const int base = (l * 2 + d) * 64 + g;
    { const float* pa = sa + base * 64 + 2 * col; P.ar0 = pa[0]; P.ar1 = pa[1]; P.ai0 = pa[16384]; P.ai1 = pa[16384 + 1]; }
#pragma unroll
    for (int blk = 0; blk < 4; ++blk) { const int part = blk >> 1, p = 2 * col + (blk & 1);
        const float* src = sbb + (size_t)part * 262144 + ((size_t)(base * 64 + p)) * 16 + 8 * h;
        const f32x4 x0 = *(const f32x4*)src, x1 = *(const f32x4*)(src + 4);
        const v4u wh = {pk2(x0.x, x0.y), pk2(x0.z, x0.w), pk2(x1.x, x1.y), pk2(x1.z, x1.w)};
        P.bbh[blk] = __builtin_bit_cast(bf16x8, wh); }
#pragma unroll
    for (int ks = 0; ks < 4; ++ks) { const int part = ks >> 1, p0 = 32 * (ks & 1) + 8 * kg;
        const float* src = (part ? a.in[I_CCIM] : a.in[I_CCRE]) + ((size_t)(base * 16 + c15)) * 64 + p0;
        const f32x4 x0 = *(const f32x4*)src, x1 = *(const f32x4*)(src + 4); const float sg = part ? -1.f : 1.f;
        const v4u w = {pk2(sg * x0.x, sg * x0.y), pk2(sg * x0.z, sg * x0.w), pk2(sg * x1.x, sg * x1.y), pk2(sg * x1.z, sg * x1.w)}; P.cm[ks] = __builtin_bit_cast(bf16x8, w); }
}
template <bool FULL, int DIR>
__device__ __forceinline__ void run(const bf16* u0, const bf16* u1, int t_lo, int t_hi, const Par& P, float& hr0, float& hi0, float& hr1, float& hi1, lptr ldsw, float* yf, bf16* yact, size_t ystep, float dc, int lane) {
    const int col = lane & 31, sq = lane >> 5, c15 = lane & 15, kg = lane >> 4;
    lptr Hs = ldsw + sq * SEQ_LDS;
    const int nch = (t_hi - t_lo) >> 4;
    const bf16* up = (((col >> 2) & 1) ? u1 : u0) + (size_t)((col & 3) + 4 * (col >> 3)) * DIN + 8 * sq;
#define S5_BPROJ(U) do { _Pragma("unroll") for (int blk_ = 0; blk_ < 4; ++blk_) { acc[blk_] = __builtin_amdgcn_mfma_f32_32x32x16_bf16(U, P.bbh[blk_], f32x16{}, 0, 0, 0); } } while (0)
#define S5_T0(ci_) (DIR == 0 ? t_lo + 16 * (ci_) : t_hi - 16 - 16 * (ci_))
#define S5_ULOAD(ci_) (*(const bf16x8*)(up + (size_t)S5_T0(ci_) * DIN))
    f32x16 acc[4]; bf16x8 unext;
    { const bf16x8 u_first = S5_ULOAD(0); unext = nch > 1 ? S5_ULOAD(1) : u_first; S5_BPROJ(u_first); }
    float yn[2][4]; bf16 un[2][4];
#define S5_PREF(T0) do { _Pragma("unroll") for (int s2_ = 0; s2_ < 2; ++s2_) _Pragma("unroll") for (int i_ = 0; i_ < 4; ++i_) { const int tok_ = (T0) + 4 * kg + i_; \
        yn[s2_][i_] = yf[((size_t)tok_ + ystep * s2_) * 1024 + c15]; un[s2_][i_] = (s2_ ? u1 : u0)[(size_t)tok_ * DIN + c15]; } } while (0)
    if constexpr (FULL && DIR == 1) S5_PREF(S5_T0(0));
    for (int ci = 0; ci < nch; ++ci) {
        const int t0 = S5_T0(ci);
        float yc[2][4]; bf16 uc[2][4];
        if constexpr (FULL && DIR == 1) {
#pragma unroll
            for (int s2 = 0; s2 < 2; ++s2)
#pragma unroll
                for (int i = 0; i < 4; ++i) { yc[s2][i] = yn[s2][i]; uc[s2][i] = un[s2][i]; }
            if (ci + 1 < nch) S5_PREF(S5_T0(ci + 1));
        }
#pragma unroll
        for (int s = 0; s < 16; ++s) { const int r = DIR == 0 ? s : 15 - s;
            const float n0r = P.ar0 * hr0 - P.ai0 * hi0 + acc[0][r], n0i = P.ar0 * hi0 + P.ai0 * hr0 + acc[2][r]; hr0 = n0r; hi0 = n0i;
            const float n1r = P.ar1 * hr1 - P.ai1 * hi1 + acc[1][r], n1i = P.ar1 * hi1 + P.ai1 * hr1 + acc[3][r]; hr1 = n1r; hi1 = n1i;
            if constexpr (FULL) { *(LAS unsigned*)(Hs + r * H_STRIDE + col * 4) = pk2(hr0, hr1); *(LAS unsigned*)(Hs + r * H_STRIDE + 128 + col * 4) = pk2(hi0, hi1); } }
        if (ci + 1 < nch) { const bf16x8 ucur = unext; if (ci + 2 < nch) unext = S5_ULOAD(ci + 2); S5_BPROJ(ucur); }
        if constexpr (FULL) {
            __builtin_amdgcn_wave_barrier();
#pragma unroll
            for (int s2 = 0; s2 < 2; ++s2) {
                f32x4 y = {0.f, 0.f, 0.f, 0.f};
#pragma unroll
                for (int ks = 0; ks < 4; ++ks) { const bf16x8 af = *(const LAS bf16x8*)(ldsw + s2 * SEQ_LDS + c15 * H_STRIDE + (32 * ks + 8 * kg) * 2); y = __builtin_amdgcn_mfma_f32_16x16x32_bf16(af, P.cm[ks], y, 0, 0, 0); }
#pragma unroll
                for (int i = 0; i < 4; ++i) { const int tok = t0 + 4 * kg + i; const size_t yo = ((size_t)tok + ystep * s2) * 1024 + c15;
                    if constexpr (DIR == 0) yf[yo] = y[i];
                    else { const float v = yc[s2][i] + y[i] + bf2f(uc[s2][i]) * dc; yact[yo] = (bf16)f2bf(gelu_tanh(v)); } }
            }
            __builtin_amdgcn_wave_barrier();
        }
    }
#undef S5_PREF
#undef S5_BPROJ
#undef S5_T0
#undef S5_ULOAD
}
__device__ __forceinline__ void ctx_unit(CArgs& a, int l, int cu, lptr ldsw, int lane) {
    const int bp = cu & 15, g = cu >> 4; const int rowbase = bp * SEQ; const int col = lane & 31, sq = lane >> 5, b = bp + 16 * sq;
    const bf16* u0 = (const bf16*)(a.ws + WS_PROJ) + (size_t)rowbase * DIN + C_U + g * 16; const bf16* u1 = u0 + (size_t)16 * SEQ * DIN;
    float* yf = (float*)(a.ws + WS_YD) + (size_t)rowbase * 1024 + g * 16; bf16* yact = (bf16*)(a.ws + WS_YACT) + (size_t)rowbase * 1024 + g * 16;
    const float dc = a.in[I_CD][l * 1024 + g * 16 + (lane & 15)];
    Par P;
    { load_par(a, l, 0, g, lane, P); float h0r = 0.f, h0i = 0.f, h1r = 0.f, h1i = 0.f; run<true, 0>(u0, u1, 0, SEQ, P, h0r, h0i, h1r, h1i, ldsw, yf, yact, (size_t)16 * SEQ, dc, lane);
      const int oi = (((b * 2 + l) * 2 + 0) * 64 + g) * 64 + 2 * col; *(v2u*)(a.out + O_CRE + oi) = (v2u){__float_as_uint(h0r), __float_as_uint(h1r)}; *(v2u*)(a.out + O_CIM + oi) = (v2u){__float_as_uint(h0i), __float_as_uint(h1i)}; }
    { load_par(a, l, 1, g, lane, P); float h0r = 0.f, h0i = 0.f, h1r = 0.f, h1i = 0.f; run<true, 1>(u0, u1, 0, SEQ, P, h0r, h0i, h1r, h1i, ldsw, yf, yact, (size_t)16 * SEQ, dc, lane);
      const int oi = (((b * 2 + l) * 2 + 1) * 64 + g) * 64 + 2 * col; *(v2u*)(a.out + O_CRE + oi) = (v2u){__float_as_uint(h0r), __float_as_uint(h1r)}; *(v2u*)(a.out + O_CIM + oi) = (v2u){__float_as_uint(h0i), __float_as_uint(h1i)}; }
}
template <int NSQ> __device__ __forceinline__ void cpow2n(float ar, float ai, float& pr, float& pi) { pr = ar; pi = ai;
#pragma unroll
    for (int i = 0; i < NSQ; ++i) { const float nr = pr * pr - pi * pi, ni = 2.f * pr * pi; pr = nr; pi = ni; } }
__device__ __forceinline__ void lat_pass1(CArgs& a, int l, int lu, lptr lds, int wave, int lane) {
    const int g = lu >> 2, seg = (lu & 3) * 8 + wave;
    const bf16* u0 = (const bf16*)(a.ws + WS_PROJ) + (size_t)MC * DIN + C_U + g * 16; const bf16* u1 = u0 + (size_t)LSEQ * DIN;
    f32x4* SEG = (f32x4*)(a.ws + WS_SEG);
    const int t_lo = seg * 128, t_hi = t_lo + 128;
    Par P;
#pragma unroll
    for (int d = 0; d < 2; ++d) { load_par(a, l, d, g, lane, P); float h0r = 0.f, h0i = 0.f, h1r = 0.f, h1i = 0.f;
        if (d == 0) run<false, 0>(u0, u1, t_lo, t_hi, P, h0r, h0i, h1r, h1i, lds, nullptr, nullptr, 0, 0.f, lane); else run<false, 1>(u0, u1, t_lo, t_hi, P, h0r, h0i, h1r, h1i, lds, nullptr, nullptr, 0, 0.f, lane);
        SEG[((size_t)(g * 2 + d) * 32 + seg) * 64 + lane] = (f32x4){h0r, h0i, h1r, h1i}; }
}
__device__ __forceinline__ void lat_pass2(CArgs& a, int l, int lu, lptr lds, int wave, int lane) {
    const int g = lu >> 2, seg = (lu & 3) * 8 + wave; const int col = lane & 31, sq = lane >> 5;
    const bf16* u0 = (const bf16*)(a.ws + WS_PROJ) + (size_t)MC * DIN + C_U + g * 16; const bf16* u1 = u0 + (size_t)LSEQ * DIN;
    float* yf = (float*)(a.ws + WS_YD) + (size_t)MC * 1024 + g * 16; bf16* yact = (bf16*)(a.ws + WS_YACT) + (size_t)MC * 1024 + g * 16;
    const float dc = a.in[I_CD][l * 1024 + g * 16 + (lane & 15)];
    const f32x4* SEG = (const f32x4*)(a.ws + WS_SEG);
    lptr ldsw = lds + wave * WAVE_LDS;
    const int t_lo = seg * 128, t_hi = t_lo + 128;
    Par P;
#pragma unroll
    for (int d = 0; d < 2; ++d) { load_par(a, l, d, g, lane, P); float p0r, p0i, p1r, p1i; cpow2n<7>(P.ar0, P.ai0, p0r, p0i); cpow2n<7>(P.ar1, P.ai1, p1r, p1i);
        const int si = (((sq * 2 + l) * 2 + d) * 64 + g) * 64 + 2 * col;
        float h0r = a.in[I_SRE][si], h0i = a.in[I_SIM][si], h1r = a.in[I_SRE][si + 1], h1i = a.in[I_SIM][si + 1];
        const int nv = d == 0 ? seg : 31 - seg;
        const f32x4* sp = SEG + ((size_t)(g * 2 + d) * 32) * 64 + lane;
        for (int k0 = 0; k0 < nv; k0 += 8) {
            f32x4 sv[8];
#pragma unroll
            for (int j = 0; j < 8; ++j) { const int k = k0 + j < nv ? k0 + j : nv - 1; const int v = d == 0 ? k : 31 - k; sv[j] = sp[(size_t)v * 64]; }
#pragma unroll
            for (int j = 0; j < 8; ++j) if (k0 + j < nv) { const f32x4 s = sv[j];
                const float n0r = p0r * h0r - p0i * h0i + s.x, n0i = p0r * h0i + p0i * h0r + s.y, n1r = p1r * h1r - p1i * h1i + s.z, n1i = p1r * h1i + p1i * h1r + s.w; h0r = n0r; h0i = n0i; h1r = n1r; h1i = n1i; }
        }
        if (d == 0) run<true, 0>(u0, u1, t_lo, t_hi, P, h0r, h0i, h1r, h1i, ldsw, yf, yact, (size_t)LSEQ, dc, lane); else run<true, 1>(u0, u1, t_lo, t_hi, P, h0r, h0i, h1r, h1i, ldsw, yf, yact, (size_t)LSEQ, dc, lane); }
}
}
__global__ void __launch_bounds__(NTHREADS, 2) fwd(Args args_by_value) {
    extern __shared__ __attribute__((aligned(16))) unsigned char lds_raw[];
    LAS unsigned char* lds = (LAS unsigned char*)lds_raw;
    volatile LAS unsigned* MISC = (volatile LAS unsigned*)(lds + MISC_OFF);
#define IDS() int tid_ = tid_of(wv); asm volatile("" : "+v"(tid_)); const int lane = tid_ & 63, wave = __builtin_amdgcn_readfirstlane(tid_ >> 6); const int G = gridDim.x, gw = blockIdx.x * NWAVES + wave, NGW = G * NWAVES; (void)lane; (void)gw; (void)NGW; (void)G; \
    CArgs* kp_ = (CArgs*)__builtin_amdgcn_kernarg_segment_ptr(); asm volatile("" : "+s"(kp_)); CArgs& args = *kp_; \
    unsigned char* ws = args.ws; const float* ada_l = (const float*)(ws + WS_ADA) + (size_t)l * 3 * 12288; bf16* HM = (bf16*)(ws + WS_HM); bf16* PROJ = (bf16*)(ws + WS_PROJ); bf16* XR = (bf16*)(ws + WS_XR); (void)ada_l; (void)HM; (void)PROJ; (void)XR
    const int wv = __builtin_amdgcn_readfirstlane((int)threadIdx.x >> 6);
    for (int u = threadIdx.x; u < (LDS_BYTES - LDSCTL_OFF) / 4; u += NTHREADS) ((LAS unsigned*)(lds + LDSCTL_OFF))[u] = 0u;
    __syncthreads();
    XcdBarrier bar;
#define GRID_BAR() do { XcdBarrier b_ = bar; asm volatile("" : "+s"(b_.x)); xcd_barrier(b_, tid_of(wv) == 0); } while (0)
    { CArgs& args0 = *(CArgs*)__builtin_amdgcn_kernarg_segment_ptr(); bar = xcd_barrier_post((unsigned*)(args0.ws + WS_CTL) + CW_BAR, MISC + 8, tid_of(wv) == 0);
      p0_ada(args0, lds, wv); }
    GRID_BAR();
    { const int l = 0; IDS(); p0_prologue(args, lds, wv);
      { LAS unsigned char* buf = lds + wave * 16384; int m = gw; if (m < M) row_dma<16>(x_row_in(args, m), buf, lane);
        for (; m < M; m += NGW) { f32x4 v[16];
          asm volatile("s_waitcnt vmcnt(0)" ::: "memory"); row_lds_f32(buf, lane, v); asm volatile("s_waitcnt lgkmcnt(0)" ::: "memory");
          if (m + NGW < M) row_dma<16>(x_row_in(args, m + NGW), buf, lane);
          ln_mod_apply(v, ada_l + (size_t)cond_of_row(m) * 12288, HM + (size_t)m * DM, lane); } } }
    GRID_BAR();

    for (int l = 0; l < DEPTH; ++l) {
        { IDS();
            pg8::Gemm g{HM, (const bf16*)(ws + WS_WIN) + (size_t)l * DIN * DM, M, DIN, DM}; pg8::StaticOrder S; S.init(M, DIN, G, (int)blockIdx.x);
            pg8::EpiBf16<0> E{PROJ, DIN, nullptr, 0, 0, 1.f};
            pg8::gemm_phase<pg8::EpiBf16<0>, pg8::StaticOrder, true, true>(lds + RING_OFF, g, S, E, wv); }
        GRID_BAR();
        { IDS();
            for (int lu = blockIdx.x; lu < 256; lu += G) s5::lat_pass1(args, l, lu, (s5::lptr)lds + wave * s5::WAVE_LDS, wave, lane);
            if (wave < 4) { for (int cu = (int)blockIdx.x * 4 + wave; cu < 1024; cu += G * 4) s5::ctx_unit(args, l, cu, (s5::lptr)lds + wave * s5::WAVE_LDS, lane); }
            else for (int m = (int)blockIdx.x * 4 + wave - 4; m < M; m += G * 4) post_row(args, l, m, lane);
            GRID_BAR();
            for (int lu = blockIdx.x; lu < 256; lu += G) s5::lat_pass2(args, l, lu, (s5::lptr)lds, wave, lane); }
        GRID_BAR();
        { IDS();
            const int xg = (int)blockIdx.x & 7, ig = (int)blockIdx.x >> 3;
            const int u_bd = G == 256 ? ((((xg >> 1) * 4 + ((xg & 1) * 2 + (ig >> 4))) * 16) + (ig & 15)) : -1;
            const int u_a = G == 256 ? (((xg * 2 + (ig >> 4)) * 16) + (ig & 15)) : -1;
            for (int u = blockIdx.x; u < 256; u += G) attn_fast_unit<1, true>(args, l, G == 256 ? u_bd : u, lds, wv);
            for (int u = blockIdx.x; u < 256; u += G) attn_fast_unit<2, true>(args, l, G == 256 ? u_bd : u, lds, wv);
            for (int u = blockIdx.x; u < 256; u += G) attn_fast_unit<1, false>(args, l, u, lds, wv);
            for (int u = blockIdx.x; u < 256; u += G) attn_fast_unit<2, false>(args, l, u, lds, wv);
            for (int u = blockIdx.x; u < 256; u += G) attn_fast_unit<0, true>(args, l, G == 256 ? u_a : u, lds, wv);
            for (int u = blockIdx.x; u < 256; u += G) attn_fast_unit<0, false>(args, l, u, lds, wv);
            pg8::Gemm g{(const bf16*)(ws + WS_YACT), (const bf16*)(ws + WS_GLU) + (size_t)l * 1024 * 1024, M, 1024, 1024}; pg8::StaticOrder S; S.init(M, 1024, G, (int)blockIdx.x);
            pg8::EpiGlu E{HM, (const bf16*)(ws + WS_YACT), PROJ, args.in[I_GLUB] + l * 1024, DM, 1024, DIN, 2048, C_G};
            pg8::gemm_phase<pg8::EpiGlu, pg8::StaticOrder, true, true>(lds + RING_OFF, g, S, E, wv); }
        GRID_BAR();
        { IDS();
            pg8::Gemm g{HM, (const bf16*)(ws + WS_WOUT) + (size_t)l * DM * DM, M, DM, DM}; pg8::StaticOrder S; S.init(M, DM, G, (int)blockIdx.x);
            pg8::EpiOut E{XR, args.in[I_XP], args.in[I_XS], l == 0 ? (const bf16*)nullptr : XR, ada_l + 8192, DN_ALPHA};
            pg8::gemm_phase<pg8::EpiOut, pg8::StaticOrder, true, true>(lds + RING_OFF, g, S, E, wv); }
        GRID_BAR();
        { IDS();
            const float* g = args.in[I_LNG] + l * DM; const float* b = args.in[I_LNB] + l * DM;
            if (l == 0) { const float* ada_n = (const float*)(ws + WS_ADA) + (size_t)3 * 12288;
                LAS unsigned char* buf = lds + wave * 16384; int m = gw; if (m < M) row_dma<8>(XR + (size_t)m * DM, buf, lane);
                for (; m < M; m += NGW) { v2u r[16];
                  asm volatile("s_waitcnt vmcnt(0)" ::: "memory"); row_lds_bf16(buf, lane, r); asm volatile("s_waitcnt lgkmcnt(0)" ::: "memory");
                  if (m + NGW < M) row_dma<8>(XR + (size_t)(m + NGW) * DM, buf, lane);
                  ln_final_mod_apply(r, g, b, XR + (size_t)m * DM, ada_n + (size_t)cond_of_row(m) * 12288, HM + (size_t)m * DM, lane); } }
            else { LAS unsigned char* buf = lds + wave * 16384; int m = gw; if (m < M) row_dma<8>(XR + (size_t)m * DM, buf, lane);
                for (; m < M; m += NGW) { v2u r[16];
                  asm volatile("s_waitcnt vmcnt(0)" ::: "memory"); row_lds_bf16(buf, lane, r); asm volatile("s_waitcnt lgkmcnt(0)" ::: "memory");
                  if (m + NGW < M) row_dma<8>(XR + (size_t)(m + NGW) * DM, buf, lane);
                  ln_final_apply(r, g, b, args.out + (size_t)m * DM, lane); } } }
        if (l + 1 < DEPTH) GRID_BAR();
    }
#undef IDS
#undef GRID_BAR
}

extern "C" void kernel_launch(void* const* d_in, const int* in_sizes, int n_in, void* d_out, int out_size, void* d_ws, size_t ws_size, hipStream_t stream) {
    static int grid = 0;
    if (grid == 0) {
        if (n_in != N_IN || (size_t)out_size != O_END || ws_size < WS_END) { fprintf(stderr, "kernel_launch: unexpected shapes: n_in %d out %d ws %zu (need %zu)\n", n_in, out_size, ws_size, (size_t)WS_END); grid = -1; return; }
        int dev = 0, cus = 0;
        if (hipGetDevice(&dev) != hipSuccess || hipDeviceGetAttribute(&cus, hipDeviceAttributeMultiprocessorCount, dev) != hipSuccess) { grid = -1; return; }
        if (hipFuncSetAttribute((const void*)fwd, hipFuncAttributeMaxDynamicSharedMemorySize, LDS_BYTES) != hipSuccess) { fprintf(stderr, "kernel_launch: hipFuncSetAttribute failed\n"); grid = -1; return; }
        int per_cu = 0;
        if (hipOccupancyMaxActiveBlocksPerMultiprocessor(&per_cu, (const void*)fwd, NTHREADS, LDS_BYTES) != hipSuccess || per_cu < 1) fprintf(stderr, "kernel_launch: note: occupancy query reports %d\n", per_cu);
        (void)hipGetLastError();
        grid = cus;
    }
    if (grid < 0) return;
    (void)hipMemsetAsync((char*)d_ws + WS_CTL, 0, CTL_ZERO_BYTES, stream);
    Args a{};
    for (int i = 0; i < N_IN; ++i) a.in[i] = (const float*)d_in[i];
    a.out = (float*)d_out; a.ws = (unsigned char*)d_ws;
    hipLaunchKernelGGL(fwd, dim3(grid), dim3(NTHREADS), LDS_BYTES, stream, a);
    const hipError_t le = hipPeekAtLastError();
    if (le != hipSuccess) fprintf(stderr, "kernel_launch: launch failed: %s\n", hipGetErrorName(le));
}
```
